# Optimizing an MI355X kernel written in HIP

```python
import math
import jax, jax.numpy as jnp
from jax import lax
import numpy as np

D_MODEL = 1024
BATCH = 4
SEQ = 4096
DEPTH = 2

CONV_WIDTH = 512
CONV_K = 3
H_SPARSE = 8
D_SPARSE = 64
H_IDX = 8
D_IDX = 32
TOPK_MAX = 256
H_DIFF = 4
D_DIFF = 64
H_DIL = 8
D_DIL = 64
DIL_GROUPS = ((128, 1), (512, 4), (2048, 16))
W_MAX = 2048
Q_BLK = 128
N_EXPERTS = 32
TOP_K = 4
D_FF = 1024
SWIGLU_LIMIT = 7.0
SWIGLU_ALPHA = 1.702
MOE_BLK = 128
DEEPNORM_ALPHA = (2 * DEPTH) ** 0.25
DEEPNORM_BETA = (8 * DEPTH) ** -0.25
LN_EPS = 1e-5
RMS_EPS = 1e-5

EVEN_SPLITS = (CONV_WIDTH, CONV_WIDTH, CONV_WIDTH,
               H_SPARSE * D_SPARSE, H_SPARSE * D_SPARSE, H_SPARSE * D_SPARSE,
               H_IDX * D_IDX, D_IDX, H_IDX)
ODD_SPLITS = (H_DIFF * 2 * D_DIFF, H_DIFF * 2 * D_DIFF, H_DIFF * 2 * D_DIFF,
              H_DIL * D_DIL, H_DIL * D_DIL, H_DIL * D_DIL)
EVEN_IN = sum(EVEN_SPLITS)
ODD_IN = sum(ODD_SPLITS)
EVEN_OUT = CONV_WIDTH + H_SPARSE * D_SPARSE
ODD_OUT = H_DIFF * 2 * D_DIFF + H_DIL * D_DIL

kernel_name = "hybrid_conv_dsa_diff_dilated_moe_deepnorm"


def alibi_slopes(n):
    return jnp.asarray([2.0 ** (-8.0 * (h + 1) / n) for h in range(n)], dtype=jnp.float32)


def layer_norm(x, g, b):
    xf = x.astype(jnp.float32)
    mu = jnp.mean(xf, -1, keepdims=True)
    var = jnp.mean(jnp.square(xf - mu), -1, keepdims=True)
    return ((xf - mu) * lax.rsqrt(var + LN_EPS) * g.astype(jnp.float32) + b.astype(jnp.float32)).astype(x.dtype)


def split_cols(h, sizes):
    offs = np.cumsum(sizes)[:-1].tolist()
    return jnp.split(h, offs, axis=-1)


def to_blocks(a):
    b, s = a.shape[:2]
    return jnp.moveaxis(a.reshape((b, s // Q_BLK, Q_BLK) + a.shape[2:]), 1, 0)


def from_blocks(a):
    a = jnp.moveaxis(a, 0, 1)
    return a.reshape((a.shape[0], a.shape[1] * a.shape[2]) + a.shape[3:])


def block_starts(seq):
    return jnp.arange(seq // Q_BLK, dtype=jnp.int32) * Q_BLK


def short_conv_mixer(gb, gc, xa, conv_w):
    z = gc * xa
    s = z.shape[1]
    zp = jnp.pad(z, ((0, 0), (CONV_K - 1, 0), (0, 0)))
    y = conv_w[0] * zp[:, CONV_K - 1:CONV_K - 1 + s]
    for j in range(1, CONV_K):
        y = y + conv_w[j] * zp[:, CONV_K - 1 - j:CONV_K - 1 - j + s]
    return gb * y


def dsa_sparse_attention(q, k, v, iq, ik, iw):
    seq = k.shape[1]
    k_sel = min(TOPK_MAX, seq // 4)
    slopes = alibi_slopes(H_SPARSE)
    scale = D_SPARSE ** -0.5
    idx_scale = (D_IDX ** -0.5) * (H_IDX ** -0.5)
    key_pos = jnp.arange(seq, dtype=jnp.int32)

    def block(args):
        qb, iqb, iwb, t0 = args
        tq = t0 + jnp.arange(Q_BLK, dtype=jnp.int32)
        rel = jax.nn.relu(jnp.einsum('bqhd,bsd->bqhs', iqb, ik).astype(jnp.float32))
        score = jnp.einsum('bqh,bqhs->bqs', iwb.astype(jnp.float32), rel) * idx_scale
        causal = key_pos[None, :] <= tq[:, None]
        score = jnp.where(causal[None], score, -jnp.inf)
        _, sel = lax.top_k(score, k_sel)
        ks = jax.vmap(lambda kk, ii: kk[ii])(k, sel)
        vs = jax.vmap(lambda vv, ii: vv[ii])(v, sel)
        logits = jnp.einsum('bqhd,bqkhd->bhqk', qb, ks).astype(jnp.float32) * scale
        dist = (tq[None, :, None] - sel).astype(jnp.float32)
        logits = logits - slopes[None, :, None, None] * dist[:, None]
        valid = (sel <= tq[None, :, None])[:, None]
        logits = jnp.where(valid, logits, -jnp.inf)
        p = jax.nn.softmax(logits, axis=-1).astype(v.dtype)
        return jnp.einsum('bhqk,bqkhd->bqhd', p, vs)

    out = lax.map(block, (to_blocks(q), to_blocks(iq), to_blocks(iw), block_starts(seq)))
    return from_blocks(out)


def diff_attention(q, k, v, lam, subln_g, lam_init):
    seq = k.shape[1]
    slopes = alibi_slopes(H_DIFF)
    scale = D_DIFF ** -0.5
    key_pos = jnp.arange(seq, dtype=jnp.int32)

    def block(args):
        qb, t0 = args
        tq = t0 + jnp.arange(Q_BLK, dtype=jnp.int32)
        logits = jnp.einsum('bqhcd,bshcd->bhcqs', qb, k).astype(jnp.float32) * scale
        dist = (tq[:, None] - key_pos[None, :])
        logits = logits - slopes[None, :, None, None, None] * dist.astype(jnp.float32)
        logits = jnp.where(dist >= 0, logits, -jnp.inf)
        p = jax.nn.softmax(logits, axis=-1)
        attn = (p[:, :, 0] - lam * p[:, :, 1]).astype(v.dtype)
        return jnp.einsum('bhqs,bshe->bqhe', attn, v)

    out = from_blocks(lax.map(block, (to_blocks(q), block_starts(seq))))
    of = out.astype(jnp.float32)
    of = of * lax.rsqrt(jnp.mean(of * of, -1, keepdims=True) + RMS_EPS) * subln_g.astype(jnp.float32)
    return (of * (1.0 - lam_init)).astype(v.dtype)


def dilated_attention(q, k, v):
    seq = k.shape[1]
    slopes = alibi_slopes(H_DIL)
    scale = D_DIL ** -0.5
    pad = ((0, 0), (W_MAX, 0), (0, 0), (0, 0))
    kp = jnp.pad(k, pad)
    vp = jnp.pad(v, pad)
    span = W_MAX + Q_BLK
    qi = np.arange(Q_BLK)
    group_dists = [np.arange(0, w + 1, d) for (w, d) in DIL_GROUPS]

    def block(args):
        qb, t0 = args
        kw = lax.dynamic_slice_in_dim(kp, t0, span, axis=1)
        vw = lax.dynamic_slice_in_dim(vp, t0, span, axis=1)
        tq = t0 + jnp.arange(Q_BLK, dtype=jnp.int32)
        lses = []
        outs = []
        for dists in group_dists:
            local = qi[:, None] + W_MAX - dists[None, :]
            kg = kw[:, local]
            vg = vw[:, local]
            logits = jnp.einsum('bqhd,bqnhd->bhqn', qb, kg).astype(jnp.float32) * scale
            logits = logits - slopes[None, :, None, None] * jnp.asarray(dists, jnp.float32)[None, None, None, :]
            valid = (tq[:, None] - jnp.asarray(dists, jnp.int32)[None, :]) >= 0
            logits = jnp.where(valid, logits, -jnp.inf)
            lse = jax.nn.logsumexp(logits, axis=-1)
            p = jnp.exp(logits - lse[..., None]).astype(v.dtype)
            outs.append(jnp.einsum('bhqn,bqnhd->bqhd', p, vg))
            lses.append(lse)
        wts = jax.nn.softmax(jnp.stack(lses, 0), axis=0)
        wts = jnp.swapaxes(wts, 2, 3)[..., None]
        y = wts[0].astype(v.dtype) * outs[0]
        for g in range(1, len(outs)):
            y = y + wts[g].astype(v.dtype) * outs[g]
        return y

    return from_blocks(lax.map(block, (to_blocks(q), block_starts(seq))))


def even_mixer(x, w_in, conv_w, w_out):
    b, s, _ = x.shape
    gb, gc, xa, q, k, v, iq, ik, iw = split_cols(x @ w_in, EVEN_SPLITS)
    ya = short_conv_mixer(gb, gc, xa, conv_w)
    hs = lambda t: t.reshape(b, s, H_SPARSE, D_SPARSE)
    yb = dsa_sparse_attention(hs(q), hs(k), hs(v), iq.reshape(b, s, H_IDX, D_IDX), ik, iw)
    y = jnp.concatenate([ya, yb.reshape(b, s, H_SPARSE * D_SPARSE)], axis=-1)
    return y @ w_out


def odd_mixer(x, w_in, lam_q1, lam_k1, lam_q2, lam_k2, subln_g, w_out, layer):
    b, s, _ = x.shape
    qc, kc, vc, qd, kd, vd = split_cols(x @ w_in, ODD_SPLITS)
    lam_init = 0.8 - 0.6 * math.exp(-0.3 * layer)
    f32 = jnp.float32
    lam = (jnp.exp(jnp.sum(lam_q1.astype(f32) * lam_k1.astype(f32)))
           - jnp.exp(jnp.sum(lam_q2.astype(f32) * lam_k2.astype(f32))) + lam_init)
    yc = diff_attention(qc.reshape(b, s, H_DIFF, 2, D_DIFF), kc.reshape(b, s, H_DIFF, 2, D_DIFF),
                        vc.reshape(b, s, H_DIFF, 2 * D_DIFF), lam, subln_g, lam_init)
    hd = lambda t: t.reshape(b, s, H_DIL, D_DIL)
    yd = dilated_attention(hd(qd), hd(kd), hd(vd))
    y = jnp.concatenate([yc.reshape(b, s, H_DIFF * 2 * D_DIFF), yd.reshape(b, s, H_DIL * D_DIL)], axis=-1)
    return y @ w_out


def expert_ffn(xb, wgu, bgu, wdn, bdn):
    h = xb @ wgu + bgu
    gate = jnp.minimum(h[..., :D_FF], SWIGLU_LIMIT)
    up = jnp.clip(h[..., D_FF:], -SWIGLU_LIMIT, SWIGLU_LIMIT)
    glu = gate * jax.nn.sigmoid(SWIGLU_ALPHA * gate)
    return ((up + 1.0) * glu) @ wdn + bdn


def moe(x, router_w, router_b, w_gu, b_gu, w_dn, b_dn):
    b, s, d = x.shape
    xt = x.reshape(b * s, d)
    n = xt.shape[0]
    logits = (xt @ router_w + router_b).astype(jnp.float32)
    top_val, top_idx = lax.top_k(logits, TOP_K)
    gates = jax.nn.softmax(top_val, axis=-1)
    flat_e = top_idx.reshape(-1)
    flat_tok = jnp.arange(n * TOP_K, dtype=jnp.int32) // TOP_K
    order = jnp.argsort(flat_e)
    e_sorted = flat_e[order]
    tok_sorted = flat_tok[order]
    gate_sorted = gates.reshape(-1)[order]
    counts = jnp.bincount(flat_e, length=N_EXPERTS)
    padded = ((counts + MOE_BLK - 1) // MOE_BLK) * MOE_BLK
    padded_end = jnp.cumsum(padded)
    padded_start = padded_end - padded
    start = jnp.cumsum(counts) - counts
    rank = jnp.arange(n * TOP_K, dtype=jnp.int32) - start[e_sorted]
    dest = padded_start[e_sorted] + rank
    n_rows = ((n * TOP_K + N_EXPERTS * (MOE_BLK - 1) + MOE_BLK - 1) // MOE_BLK) * MOE_BLK
    n_blocks = n_rows // MOE_BLK
    row_tok = jnp.zeros((n_rows,), jnp.int32).at[dest].set(tok_sorted)
    blk_e = jnp.clip(jnp.searchsorted(padded_end, jnp.arange(n_blocks) * MOE_BLK, side='right'),
                     0, N_EXPERTS - 1)
    xb = xt[row_tok].reshape(n_blocks, MOE_BLK, d)
    yb = lax.map(lambda a: expert_ffn(a[0], w_gu[a[1]], b_gu[a[1]], w_dn[a[1]], b_dn[a[1]]), (xb, blk_e))
    y_assign = yb.reshape(n_rows, d)[dest].astype(jnp.float32)
    out = jnp.zeros((n, d), jnp.float32).at[tok_sorted].add(gate_sorted[:, None] * y_assign)
    return out.astype(x.dtype).reshape(b, s, d)


def setup_inputs(seed: int = 0) -> dict:
    key = jax.random.key(seed)
    keys = iter(jax.random.split(key, 64))
    d = D_MODEL

    def nrm(shape, sc):
        return jax.random.normal(next(keys), shape, jnp.float32) * sc

    inp = {"x": nrm((BATCH, SEQ, d), 1.0)}
    for layer in range(DEPTH):
        sfx = "_%d" % layer
        if layer % 2 == 0:
            inp["w_in" + sfx] = nrm((d, EVEN_IN), d ** -0.5)
            inp["conv_w" + sfx] = nrm((CONV_K, CONV_WIDTH), 0.5)
            inp["w_out" + sfx] = nrm((EVEN_OUT, d), EVEN_OUT ** -0.5 * DEEPNORM_BETA)
        else:
            inp["w_in" + sfx] = nrm((d, ODD_IN), d ** -0.5)
            inp["lam_q1" + sfx] = nrm((D_DIFF,), 0.1)
            inp["lam_k1" + sfx] = nrm((D_DIFF,), 0.1)
            inp["lam_q2" + sfx] = nrm((D_DIFF,), 0.1)
            inp["lam_k2" + sfx] = nrm((D_DIFF,), 0.1)
            inp["subln_g" + sfx] = 1.0 + nrm((2 * D_DIFF,), 0.01)
            inp["w_out" + sfx] = nrm((ODD_OUT, d), ODD_OUT ** -0.5 * DEEPNORM_BETA)
        inp["ln_mix_g" + sfx] = 1.0 + nrm((d,), 0.01)
        inp["ln_mix_b" + sfx] = nrm((d,), 0.01)
        inp["router_w" + sfx] = nrm((d, N_EXPERTS), d ** -0.5)
        inp["router_b" + sfx] = nrm((N_EXPERTS,), 0.01)
        inp["w_gu" + sfx] = nrm((N_EXPERTS, d, 2 * D_FF), d ** -0.5)
        inp["b_gu" + sfx] = nrm((N_EXPERTS, 2 * D_FF), 0.01)
        inp["w_dn" + sfx] = nrm((N_EXPERTS, D_FF, d), D_FF ** -0.5 * DEEPNORM_BETA)
        inp["b_dn" + sfx] = nrm((N_EXPERTS, d), 0.01)
        inp["ln_ffn_g" + sfx] = 1.0 + nrm((d,), 0.01)
        inp["ln_ffn_b" + sfx] = nrm((d,), 0.01)
    return inp


def reference(x,
              w_in_0, conv_w_0, w_out_0, ln_mix_g_0, ln_mix_b_0,
              router_w_0, router_b_0, w_gu_0, b_gu_0, w_dn_0, b_dn_0, ln_ffn_g_0, ln_ffn_b_0,
              w_in_1, lam_q1_1, lam_k1_1, lam_q2_1, lam_k2_1, subln_g_1, w_out_1, ln_mix_g_1, ln_mix_b_1,
              router_w_1, router_b_1, w_gu_1, b_gu_1, w_dn_1, b_dn_1, ln_ffn_g_1, ln_ffn_b_1):
    mixer_params = [(w_in_0, conv_w_0, w_out_0),
                    (w_in_1, lam_q1_1, lam_k1_1, lam_q2_1, lam_k2_1, subln_g_1, w_out_1)]
    ln_mix = [(ln_mix_g_0, ln_mix_b_0), (ln_mix_g_1, ln_mix_b_1)]
    moe_params = [(router_w_0, router_b_0, w_gu_0, b_gu_0, w_dn_0, b_dn_0),
                  (router_w_1, router_b_1, w_gu_1, b_gu_1, w_dn_1, b_dn_1)]
    ln_ffn = [(ln_ffn_g_0, ln_ffn_b_0), (ln_ffn_g_1, ln_ffn_b_1)]
    for layer in range(DEPTH):
        if layer % 2 == 0:
            m = even_mixer(x, *mixer_params[layer])
        else:
            m = odd_mixer(x, *mixer_params[layer], layer)
        x = layer_norm(DEEPNORM_ALPHA * x + m, *ln_mix[layer])
        f = moe(x, *moe_params[layer])
        x = layer_norm(DEEPNORM_ALPHA * x + f, *ln_ffn[layer])
    return x
```

```cpp
#include <hip/hip_runtime.h>
#include <hip/hip_cooperative_groups.h>
#include <cstdio>
#include <cstdint>
#include <cmath>
namespace cg = cooperative_groups;

#define LAS __attribute__((address_space(3)))
#define GAS __attribute__((address_space(1)))
typedef unsigned short bf16_t;
typedef short bf16x8 __attribute__((ext_vector_type(8)));
typedef float f32x4 __attribute__((ext_vector_type(4)));
typedef float f32x2 __attribute__((ext_vector_type(2)));
typedef unsigned u32x4 __attribute__((ext_vector_type(4)));
typedef unsigned u32x2 __attribute__((ext_vector_type(2)));

constexpr int B_ = 4, S_ = 4096, D_ = 1024, NTOK = B_ * S_;
constexpr int EVEN_IN = 3368, EVEN_PAD = 3584, ODD_IN = 3072;
constexpr int NE = 32, TOPK = 4, DFF = 1024;
constexpr float ALPHA = 1.41421356237f;
constexpr float LN_EPS = 1e-5f, RMS_EPS = 1e-5f;
constexpr int MAXTILES = NTOK * TOPK / 256 + NE;
constexpr int MAXROWS = MAXTILES * 256;
constexpr int E_GB = 0, E_GC = 512, E_XA = 1024, E_Q = 1536, E_K = 2048, E_V = 2560, E_IQ = 3072, E_IK = 3328, E_IW = 3360;
constexpr int O_QC = 0, O_KC = 512, O_VC = 1024, O_QD = 1536, O_KD = 2048, O_VD = 2560;
constexpr int NWAVES = 8, NTHR = 512;

constexpr size_t MiB = 1u << 20;
constexpr size_t WS_CTL = 0, CTL_ZERO_BYTES = 1 * MiB;
constexpr size_t WS_SLOT = 2 * MiB;
constexpr size_t WS_TKE = 4 * MiB, WS_TKR = 5 * MiB, WS_TKG = 6 * MiB;
constexpr size_t WS_WIN = 8 * MiB, WS_WOUT = 16 * MiB, WS_WGU = 18 * MiB, WS_WDN = 146 * MiB;
constexpr size_t WS_XB = 210 * MiB;
constexpr size_t WS_H = 242 * MiB;
constexpr size_t WS_Y = 354 * MiB;
constexpr size_t WS_MB = 386 * MiB;
constexpr size_t WS_ACT = 242 * MiB;
constexpr size_t WS_YA = 418 * MiB;
constexpr size_t WS_X1 = 562 * MiB;
constexpr size_t WS_X1B = 626 * MiB;
constexpr size_t WS_X2 = 658 * MiB;
constexpr size_t WS_W1OFF = 714 * MiB;
constexpr size_t WS_END = 924 * MiB;
constexpr int CW_BAR = 4096;
constexpr int CW_CONV = 80000;
constexpr int CW_BCNT = 65536;

constexpr int RING_BYTES = 131072;
constexpr int CTL_OFF = RING_BYTES, MISC_OFF = CTL_OFF + 320, TILE_E_OFF = CTL_OFF + 1024, TILE_F_OFF = CTL_OFF + 2304, EBASE_OFF = CTL_OFF + 3584, ECNT_OFF = CTL_OFF + 3744;
constexpr int ROUTE_OFF = CTL_OFF + 6144;
constexpr int LDS_BYTES = 147456;

#define LDS_WAIT() asm volatile("s_waitcnt lgkmcnt(0)" ::: "memory")
#define VM_WAIT() asm volatile("s_waitcnt vmcnt(0)" ::: "memory")
__device__ __forceinline__ unsigned f2bf(float f) { unsigned u = __builtin_bit_cast(unsigned, f); return (u + 0x7fffu + ((u >> 16) & 1u)) >> 16; }
__device__ __forceinline__ unsigned pk2(float lo, float hi) { return f2bf(lo) | (f2bf(hi) << 16); }
__device__ __forceinline__ float bf2f(unsigned h) { return __builtin_bit_cast(float, h << 16); }
__device__ __forceinline__ float bflo(unsigned w) { return __builtin_bit_cast(float, w << 16); }
__device__ __forceinline__ float bfhi(unsigned w) { return __builtin_bit_cast(float, w & 0xffff0000u); }
__device__ __forceinline__ float wave_sum(float v) {
#pragma unroll
    for (int o = 1; o < 64; o <<= 1) v += __shfl_xor(v, o);
    return v;
}
__device__ __forceinline__ float wave_max(float v) {
#pragma unroll
    for (int o = 1; o < 64; o <<= 1) v = fmaxf(v, __shfl_xor(v, o));
    return v;
}
template <int CTRL, int ROWMASK> __device__ __forceinline__ float dpp_mov(float v, float old) { return __builtin_bit_cast(float, __builtin_amdgcn_update_dpp(__builtin_bit_cast(int, old), __builtin_bit_cast(int, v), CTRL, ROWMASK, 0xF, false)); }
__device__ __forceinline__ float wave_sum_u(float v) {
    v += dpp_mov<0xB1, 0xF>(v, 0.f); v += dpp_mov<0x4E, 0xF>(v, 0.f); v += dpp_mov<0x141, 0xF>(v, 0.f); v += dpp_mov<0x140, 0xF>(v, 0.f);
    v += dpp_mov<0x142, 0xA>(v, 0.f); v += dpp_mov<0x143, 0xC>(v, 0.f);
    return __builtin_bit_cast(float, __builtin_amdgcn_readlane(__builtin_bit_cast(int, v), 63));
}
__device__ __forceinline__ float wave_max_u(float v) {
    const float ninf = -INFINITY;
    v = fmaxf(v, dpp_mov<0xB1, 0xF>(v, ninf)); v = fmaxf(v, dpp_mov<0x4E, 0xF>(v, ninf)); v = fmaxf(v, dpp_mov<0x141, 0xF>(v, ninf)); v = fmaxf(v, dpp_mov<0x140, 0xF>(v, ninf));
    v = fmaxf(v, dpp_mov<0x142, 0xA>(v, ninf)); v = fmaxf(v, dpp_mov<0x143, 0xC>(v, ninf));
    return __builtin_bit_cast(float, __builtin_amdgcn_readlane(__builtin_bit_cast(int, v), 63));
}
__device__ __forceinline__ int wave_sum_iu(int v) {
#define DPPI(x, C, M) __builtin_amdgcn_update_dpp(0, (x), C, M, 0xF, false)
    v += DPPI(v, 0xB1, 0xF); v += DPPI(v, 0x4E, 0xF); v += DPPI(v, 0x141, 0xF); v += DPPI(v, 0x140, 0xF); v += DPPI(v, 0x142, 0xA); v += DPPI(v, 0x143, 0xC);
#undef DPPI
    return __builtin_amdgcn_readlane(v, 63);
}
__device__ __forceinline__ unsigned cvt_pk_bf16(float lo, float hi) { unsigned r; asm volatile("v_cvt_pk_bf16_f32 %0, %1, %2" : "=v"(r) : "v"(lo), "v"(hi)); return r; }

__device__ __forceinline__ int fresh_lane() { int o_ = -1; asm volatile("" : "+v"(o_)); const unsigned m_ = (unsigned)__builtin_amdgcn_readfirstlane(o_); return (int)__builtin_amdgcn_mbcnt_hi(m_, __builtin_amdgcn_mbcnt_lo(m_, 0u)); }
namespace pg8 {
constexpr int BM = 256, BK = 64, HALF = 128, HTB = HALF * BK * 2, STAGE_BYTES = 8 * HTB, NXCD = 8, WGM = 8;
__host__ __device__ __forceinline__ int lds_byte(int r, int c) { const int st = (r >> 4) * 2 + (c >> 5), rr = r & 15, cc = c & 31, ob = rr * 64 + cc * 2; return st * 1024 + (ob ^ (((ob >> 9) & 1) << 5)); }
__host__ __device__ __forceinline__ void stage_rc(int b, int& R, int& C) { const int st = b / 1024, sb = b % 1024, swz = sb ^ (((sb >> 9) & 1) << 5); R = (st >> 1) * 16 + swz / 64; C = (st & 1) * 32 + (swz % 64) / 2; }
__host__ __device__ __forceinline__ int perm32(int rho) { const int n = rho >> 4, i = rho & 15; return 8 * (i >> 2) + 4 * n + (i & 3); }
struct Unit { int pm, pn; };

struct DenseSched {
    const char* A; const char* Bt; int nM, nN, nwg, G, c; size_t tstep;
    __device__ void init(const void* A_, const void* Bt_, int M, int N, int K, int G_, int c_) { A = (const char*)A_; Bt = (const char*)Bt_; nM = M / BM; nN = N / BM; nwg = nM * nN; G = G_; c = c_; tstep = (size_t)BM * K * 2; }
    __device__ bool next(int i, Unit& u) const {
        const long L = (long)i * G + c; if (L >= nwg) return false;
        int wgid = (int)L; { const int q = nwg / NXCD, r = nwg % NXCD, xcd = wgid % NXCD, off = wgid / NXCD; wgid = (xcd < r ? xcd * (q + 1) : r * (q + 1) + (xcd - r) * q) + off; }
        const int nig = WGM * nN, gid = wgid / nig, fm = gid * WGM, gsz = (nM - fm) < WGM ? (nM - fm) : WGM;
        u.pm = fm + ((wgid % nig) % gsz); u.pn = (wgid % nig) / gsz; return true;
    }
    __device__ __forceinline__ const char* a_base(const Unit& u) const { return A + (size_t)u.pm * tstep; }
    __device__ __forceinline__ const char* b_base(const Unit& u) const { return Bt + (size_t)u.pn * tstep; }
    __device__ __forceinline__ unsigned row_off(const Unit&, int) const { return 0u; }
};
struct MoeSched {
    const char* A; const char* Bt; const int* slot_tok; const LAS int* tile_e; const LAS int* tile_f; const LAS int* ecnt;
    int n_units, NPN, G, c; size_t bexp; bool gather;
    __device__ __forceinline__ int tile_off() const { return (c % NXCD) * (G / NXCD / NPN) + (c / NXCD) / NPN; }
    __device__ bool next(int i, Unit& u) const {
        if (G % (NXCD * NPN) != 0) { const long L = (long)i * G + c; if (L >= n_units) return false; u.pm = (int)(L / NPN); u.pn = (int)(L % NPN); return true; }
        const int pm = i * (G / NPN) + tile_off(); if (pm >= n_units / NPN) return false; u.pm = pm; u.pn = (c / NXCD) % NPN; return true; }
    __device__ __forceinline__ int my_units() const { if (G % (NXCD * NPN) != 0) return (int)((n_units - c + G - 1) / G); const int nt_ = n_units / NPN, o = tile_off(), tpr = G / NPN; return o < nt_ ? (nt_ - o + tpr - 1) / tpr : 0; }
    __device__ __forceinline__ const char* a_base(const Unit& u) const { return gather ? A : A + (size_t)u.pm * ((size_t)BM * 1024 * 2); }
    __device__ __forceinline__ const char* b_base(const Unit& u) const { return Bt + (size_t)tile_e[u.pm] * bexp + (size_t)u.pn * ((size_t)BM * 1024 * 2); }
    __device__ __forceinline__ unsigned row_off(const Unit& u, int r) const {
        const int e = tile_e[u.pm], rk = tile_f[u.pm] * BM + r; const int tok = rk < ecnt[e] ? slot_tok[e * NTOK + rk] : 0;
        return (unsigned)tok * 2048u;
    }
};

struct EpiBf16 {
    static constexpr bool PERM = true;
    bf16_t* O; int ldc;
    __device__ __forceinline__ void operator()(const f32x4 (&acc)[2][2][4][2], const Unit& u, int wr, int wc, int fr, int fq) const {
        const int row0 = u.pm * BM + wr * 64 + fr, col0 = u.pn * BM + wc * 32 + 8 * fq;
#pragma unroll
        for (int ai = 0; ai < 2; ++ai)
#pragma unroll
            for (int m = 0; m < 4; ++m) { bf16_t* rowp = O + (size_t)(row0 + ai * HALF + m * 16) * ldc + col0;
#pragma unroll
                for (int bj = 0; bj < 2; ++bj) { const f32x4 v0 = acc[ai][bj][m][0], v1 = acc[ai][bj][m][1];
                    u32x4 w; w.x = cvt_pk_bf16(v0[0], v0[1]); w.y = cvt_pk_bf16(v0[2], v0[3]); w.z = cvt_pk_bf16(v1[0], v1[1]); w.w = cvt_pk_bf16(v1[2], v1[3]);
                    *(u32x4*)(rowp + bj * HALF) = w; } }
    }
};
struct EpiAct {
    static constexpr bool PERM = true;
    bf16_t* O; const float* bias; const LAS int* tile_e;
    __device__ __forceinline__ void operator()(const f32x4 (&acc)[2][2][4][2], const Unit& u, int wr, int wc, int fr, int fq) const {
        const int e = tile_e[u.pm];
        const float* bg = bias + (size_t)e * 2 * DFF + u.pn * HALF + wc * 32 + 8 * fq;
        const f32x4 bg0 = *(const f32x4*)bg, bg1 = *(const f32x4*)(bg + 4), bu0 = *(const f32x4*)(bg + DFF), bu1 = *(const f32x4*)(bg + DFF + 4);
        const int row0 = u.pm * BM + wr * 64 + fr, col0 = u.pn * HALF + wc * 32 + 8 * fq;
#pragma unroll
        for (int ai = 0; ai < 2; ++ai)
#pragma unroll
            for (int m = 0; m < 4; ++m) {
                f32x4 g0 = acc[ai][0][m][0] + bg0, g1 = acc[ai][0][m][1] + bg1, u0 = acc[ai][1][m][0] + bu0, u1 = acc[ai][1][m][1] + bu1;
                float r[8];
#pragma unroll
                for (int j = 0; j < 8; ++j) { float gt = j < 4 ? g0[j & 3] : g1[j & 3], up = j < 4 ? u0[j & 3] : u1[j & 3];
                    gt = fminf(gt, 7.0f); up = fminf(fmaxf(up, -7.0f), 7.0f);
                    const float sg = __builtin_amdgcn_rcpf(1.0f + __builtin_amdgcn_exp2f(-1.702f * 1.4426950408889634f * gt));
                    r[j] = (up + 1.0f) * (gt * sg); }
                u32x4 w; w.x = cvt_pk_bf16(r[0], r[1]); w.y = cvt_pk_bf16(r[2], r[3]); w.z = cvt_pk_bf16(r[4], r[5]); w.w = cvt_pk_bf16(r[6], r[7]);
                *(u32x4*)(O + (size_t)(row0 + ai * HALF + m * 16) * DFF + col0) = w; }
    }
};
struct EpiBias {
    static constexpr bool PERM = true;
    bf16_t* O; const float* bias; const LAS int* tile_e;
    __device__ __forceinline__ void operator()(const f32x4 (&acc)[2][2][4][2], const Unit& u, int wr, int wc, int fr, int fq) const {
        const int e = tile_e[u.pm];
        const int row0 = u.pm * BM + wr * 64 + fr, col0 = u.pn * BM + wc * 32 + 8 * fq;
        const float* bp = bias + (size_t)e * D_ + col0;
        f32x4 bv[2][2];
#pragma unroll
        for (int bj = 0; bj < 2; ++bj)
#pragma unroll
            for (int n = 0; n < 2; ++n) bv[bj][n] = *(const f32x4*)(bp + bj * HALF + 4 * n);
#pragma unroll
        for (int ai = 0; ai < 2; ++ai)
#pragma unroll
            for (int m = 0; m < 4; ++m) { bf16_t* rowp = O + (size_t)(row0 + ai * HALF + m * 16) * D_ + col0;
#pragma unroll
                for (int bj = 0; bj < 2; ++bj) { const f32x4 v0 = acc[ai][bj][m][0] + bv[bj][0], v1 = acc[ai][bj][m][1] + bv[bj][1];
                    u32x4 w; w.x = cvt_pk_bf16(v0[0], v0[1]); w.y = cvt_pk_bf16(v0[2], v0[3]); w.z = cvt_pk_bf16(v1[0], v1[1]); w.w = cvt_pk_bf16(v1[2], v1[3]);
                    *(u32x4*)(rowp + bj * HALF) = w; } }
    }
};

template <class Epi, class Sched, bool GATHER>
__device__ __forceinline__ void gemm_phase(LAS unsigned char* lds, const int K, const Sched& S, const Epi& E, const int tid) {
    const int wid = __builtin_amdgcn_readfirstlane(tid >> 6), lane = tid & 63, wr = wid >> 2, wc = wid & 3, fr = lane & 15, fq = lane >> 4;
    const int nt = K / BK;
    unsigned voffA[2], voffB[2]; int RA[2], CA2[2];
#pragma unroll
    for (int i = 0; i < 2; ++i) { int R, C; stage_rc(tid * 16 + i * 8192, R, C); const int Rb = Epi::PERM ? ((R & ~31) + perm32(R & 31)) : R;
        voffA[i] = (unsigned)(R * K + C) * 2u; voffB[i] = (unsigned)(Rb * K + C) * 2u; RA[i] = R; CA2[i] = C * 2; }
    const size_t kstep = (size_t)(BK * 2);
    const size_t hstep = (size_t)HALF * K * 2;
    const unsigned ldsw = (unsigned)wid * 1024u;
    const int aoff = lds_byte(wr * 64 + fr, fq * 8), boff = lds_byte(wc * 32 + fr, fq * 8);
#define PG8_SA(b, h) (((b) * 2 + (h)) * HTB)
#define PG8_SB(b, h) ((4 + (b) * 2 + (h)) * HTB)
#define PG8_STAGE(bufoff, gbase, voff) do { _Pragma("unroll") for (int _i = 0; _i < 2; ++_i) \
        __builtin_amdgcn_global_load_lds((const unsigned*)((const char*)(gbase) + (voff)[_i]), (LAS unsigned*)(lds + (bufoff) + ldsw + _i * 8192), 16, 0, 0); } while (0)
#define PG8_STAGE_A(bufoff, gbase, h, vg) do { if constexpr (GATHER) { PG8_STAGE(bufoff, gbase, (vg)[h]); } else { PG8_STAGE(bufoff, (gbase) + (h) * hstep, voffA); } } while (0)
#define PG8_LDA(dst, b, h) do { _Pragma("unroll") for (int m = 0; m < 4; ++m) _Pragma("unroll") for (int k = 0; k < 2; ++k) dst[m][k] = *(const LAS bf16x8*)(lds + PG8_SA(b, h) + aoff + m * 2048 + k * 1024); } while (0)
#define PG8_LDB(dst, b, h) do { _Pragma("unroll") for (int n = 0; n < 2; ++n) _Pragma("unroll") for (int k = 0; k < 2; ++k) dst[n][k] = *(const LAS bf16x8*)(lds + PG8_SB(b, h) + boff + n * 2048 + k * 1024); } while (0)
#define PG8_MMA(ai, bj, At, Bt) do { __builtin_amdgcn_s_setprio(1); _Pragma("unroll") for (int m = 0; m < 4; ++m) _Pragma("unroll") for (int n = 0; n < 2; ++n) _Pragma("unroll") for (int k = 0; k < 2; ++k) \
        acc[ai][bj][m][n] = __builtin_amdgcn_mfma_f32_16x16x32_bf16(Bt[n][k], At[m][k], acc[ai][bj][m][n], 0, 0, 0); __builtin_amdgcn_s_setprio(0); } while (0)
#define PG8_WAIT_V(n) asm volatile("s_waitcnt vmcnt(" #n ")" ::: "memory")
#define PG8_WAIT_L(n) asm volatile("s_waitcnt lgkmcnt(" #n ")" ::: "memory")
#define PG8_BAR __builtin_amdgcn_s_barrier()
#define PG8_SCHED __builtin_amdgcn_sched_barrier(0)
    Unit cur, nxt; int ui = 0;
    if (!S.next(0, cur)) return;
    f32x4 acc[2][2][4][2];
#pragma unroll
    for (int a = 0; a < 2; ++a)
#pragma unroll
        for (int b = 0; b < 2; ++b)
#pragma unroll
            for (int m = 0; m < 4; ++m)
#pragma unroll
                for (int n = 0; n < 2; ++n) acc[a][b][m][n] = (f32x4){0.f, 0.f, 0.f, 0.f};
    bf16x8 At[4][2], B0[2][2], B1[2][2];
    unsigned vgc[2][2] = {{0u, 0u}, {0u, 0u}}, vgn[2][2] = {{0u, 0u}, {0u, 0u}};
    if constexpr (GATHER) {
#pragma unroll
        for (int h = 0; h < 2; ++h)
#pragma unroll
            for (int i = 0; i < 2; ++i) vgc[h][i] = S.row_off(cur, h * HALF + RA[i]) + (unsigned)CA2[i];
    }
    const char* cA = S.a_base(cur); const char* cB = S.b_base(cur);
    PG8_STAGE(PG8_SB(0, 0), cB, voffB); PG8_STAGE(PG8_SB(0, 1), cB + hstep, voffB); PG8_STAGE_A(PG8_SA(0, 0), cA, 0, vgc); PG8_STAGE_A(PG8_SA(0, 1), cA, 1, vgc);
    if (wr == 1) PG8_BAR;
    PG8_WAIT_V(2); PG8_BAR;
    PG8_STAGE(PG8_SB(1, 0), cB + kstep, voffB); PG8_STAGE_A(PG8_SA(1, 0), cA + kstep, 0, vgc); PG8_STAGE(PG8_SB(1, 1), cB + hstep + kstep, voffB);
    PG8_WAIT_V(6); PG8_BAR;
    for (;;) {
        const bool has_next = S.next(ui + 1, nxt);
        const char* nA = has_next ? S.a_base(nxt) : cA; const char* nB = has_next ? S.b_base(nxt) : cB;
        if constexpr (GATHER) {
            if (has_next) {
#pragma unroll
                for (int h = 0; h < 2; ++h)
#pragma unroll
                    for (int i = 0; i < 2; ++i) vgn[h][i] = S.row_off(nxt, h * HALF + RA[i]) + (unsigned)CA2[i];
            } else {
#pragma unroll
                for (int h = 0; h < 2; ++h)
#pragma unroll
                    for (int i = 0; i < 2; ++i) vgn[h][i] = vgc[h][i];
            }
        }
        for (int t = 0; t < nt; t += 2) {
            const bool last = (t == nt - 2);
            const char* a1 = cA + (size_t)(t + 1) * kstep;
            const char* a2 = last ? nA : cA + (size_t)(t + 2) * kstep; const char* b2 = last ? nB : cB + (size_t)(t + 2) * kstep;
            const char* a3 = a2 + kstep; const char* b3 = b2 + kstep;
            unsigned vg2[2][2];
#pragma unroll
            for (int h = 0; h < 2; ++h)
#pragma unroll
                for (int i = 0; i < 2; ++i) vg2[h][i] = last ? vgn[h][i] : vgc[h][i];
            PG8_LDB(B0, 0, 0); PG8_LDB(B1, 0, 1); PG8_SCHED; PG8_LDA(At, 0, 0); PG8_STAGE_A(PG8_SA(1, 1), a1, 1, vgc);
            PG8_WAIT_V(8); PG8_WAIT_L(0); PG8_BAR; PG8_MMA(0, 0, At, B0); PG8_MMA(0, 1, At, B1); PG8_BAR; PG8_SCHED;
            PG8_LDA(At, 0, 1); PG8_STAGE(PG8_SB(0, 0), b2, voffB); PG8_STAGE(PG8_SB(0, 1), b2 + hstep, voffB); PG8_STAGE_A(PG8_SA(0, 0), a2, 0, vg2);
            PG8_WAIT_V(8); PG8_WAIT_L(0); PG8_BAR; PG8_MMA(1, 0, At, B0); PG8_MMA(1, 1, At, B1); PG8_BAR; PG8_SCHED;
            PG8_LDB(B0, 1, 0); PG8_LDB(B1, 1, 1); PG8_SCHED; PG8_LDA(At, 1, 0); PG8_STAGE_A(PG8_SA(0, 1), a2, 1, vg2);
            PG8_WAIT_V(8); PG8_WAIT_L(0); PG8_BAR; PG8_MMA(0, 0, At, B0); PG8_MMA(0, 1, At, B1); PG8_BAR; PG8_SCHED;
            PG8_LDA(At, 1, 1); PG8_STAGE(PG8_SB(1, 0), b3, voffB); PG8_STAGE(PG8_SB(1, 1), b3 + hstep, voffB); PG8_STAGE_A(PG8_SA(1, 0), a3, 0, vg2);
            PG8_WAIT_V(8); PG8_WAIT_L(0); PG8_BAR; PG8_MMA(1, 0, At, B0); PG8_MMA(1, 1, At, B1); PG8_BAR; PG8_SCHED;
        }
        if (wr == 0) PG8_BAR;
        E(acc, cur, wr, wc, fr, fq);
        if (!has_next) break;
#pragma unroll
        for (int a = 0; a < 2; ++a)
#pragma unroll
            for (int b = 0; b < 2; ++b)
#pragma unroll
                for (int m = 0; m < 4; ++m)
#pragma unroll
                    for (int n = 0; n < 2; ++n) acc[a][b][m][n] = (f32x4){0.f, 0.f, 0.f, 0.f};
        cur = nxt; cA = nA; cB = nB; ++ui;
        if constexpr (GATHER) {
#pragma unroll
            for (int h = 0; h < 2; ++h)
#pragma unroll
                for (int i = 0; i < 2; ++i) vgc[h][i] = vgn[h][i];
        }
        if (wr == 1) PG8_BAR;
    }
    PG8_WAIT_V(0);
    PG8_BAR;
#undef PG8_SA
#undef PG8_SB
#undef PG8_STAGE
#undef PG8_STAGE_A
#undef PG8_LDA
#undef PG8_LDB
#undef PG8_MMA
#undef PG8_WAIT_V
#undef PG8_WAIT_L
#undef PG8_BAR
#undef PG8_SCHED
}
}

#define XB_TMO      128
#define XB_XCNT(j)  (256  + 64 * (j))
#define XB_XSUB(j)  (1280 + 64 * (j))
#define XB_XGEN(j)  (2304 + 64 * (j))
#define XB_TOP      3328
#define XB_TOPGEN   3392
#define XCD_BAR_WORDS 3456
#define XB_SPIN_CAP (1u << 18)
__device__ __forceinline__ unsigned xb_ld(unsigned* p)              { return __hip_atomic_load(p, __ATOMIC_RELAXED, __HIP_MEMORY_SCOPE_AGENT); }
__device__ __forceinline__ unsigned xb_add(unsigned* p, unsigned v) { return __hip_atomic_fetch_add(p, v, __ATOMIC_RELAXED, __HIP_MEMORY_SCOPE_AGENT); }
__device__ __forceinline__ unsigned xb_xcc_id() { return (unsigned)__builtin_amdgcn_s_getreg((3 << 11) | 20) & 0xFu; }
#define XB_SPIN(cond, bar) do { unsigned _sp = 0; while (cond) { __builtin_amdgcn_s_sleep(1); \
    if ((++_sp & 255u) == 0u) { if (xb_ld(&(bar)[XB_TMO])) break; if (_sp > XB_SPIN_CAP) { atomicAdd(&(bar)[XB_TMO], 1u); break; } } } } while (0)
struct XcdBarrier { unsigned* bar; unsigned x; volatile LAS unsigned* st; };
__device__ __forceinline__ XcdBarrier xcd_barrier_post(unsigned* bar, volatile LAS unsigned* st) {
    XcdBarrier b; b.bar = bar; b.x = xb_xcc_id(); b.st = st;
    if (threadIdx.x == 0) (void)xb_add(&bar[XB_XCNT(b.x)], 1u);
    return b;
}
__device__ __forceinline__ void xcd_barrier_complete(unsigned* bar, unsigned x, unsigned& nloc, unsigned& nx) {
    const unsigned G = gridDim.x * gridDim.y * gridDim.z;
    unsigned sum, cnt, mine, sp = 0u;
    for (;;) {
        sum = 0u; cnt = 0u; mine = 0u;
#pragma unroll
        for (unsigned j = 0; j < 16; ++j) { const unsigned c = xb_ld(&bar[XB_XCNT(j)]); sum += c; cnt += (c > 0u) ? 1u : 0u; mine = (j == x) ? c : mine; }
        if (sum == G) break;
        __builtin_amdgcn_s_sleep(1);
        if ((++sp & 255u) == 0u) { if (xb_ld(&bar[XB_TMO])) break; if (sp > XB_SPIN_CAP) { atomicAdd(&bar[XB_TMO], 1u); break; } }
    }
    nloc = mine > 0u ? mine : 1u; nx = cnt > 0u ? cnt : 1u;
}
__device__ __forceinline__ void xcd_barrier(const XcdBarrier& b, const bool leader) {
    asm volatile("s_waitcnt vmcnt(0)" ::: "memory");
    __syncthreads();
    if (leader) {
        unsigned* bar = b.bar; unsigned bx_ = b.x;
        asm volatile("" : "+s"(bar), "+s"(bx_));
        __builtin_amdgcn_s_waitcnt(0);
        unsigned nloc = b.st[0], nx = b.st[1];
        if (nloc == 0u) { xcd_barrier_complete(bar, bx_, nloc, nx); b.st[0] = nloc; b.st[1] = nx; }
        const unsigned old = xb_add(&bar[XB_XSUB(bx_)], 1u);
        const unsigned gen = old / nloc;
        if (old + 1u == (gen + 1u) * nloc) {
            __builtin_amdgcn_fence(__ATOMIC_RELEASE, "agent");
            asm volatile("s_waitcnt vmcnt(0)" ::: "memory");
            const unsigned og = xb_add(&bar[XB_TOP], 1u);
            const unsigned tg = og / nx;
            if (og + 1u == (tg + 1u) * nx) xb_add(&bar[XB_TOPGEN], 1u);
            else XB_SPIN(xb_ld(&bar[XB_TOPGEN]) == tg, bar);
            __builtin_amdgcn_fence(__ATOMIC_ACQUIRE, "agent");
            xb_add(&bar[XB_XGEN(bx_)], 1u);
            asm volatile("s_waitcnt vmcnt(0)" ::: "memory");
        } else {
            XB_SPIN(xb_ld(&bar[XB_XGEN(bx_)]) == gen, bar);
            __builtin_amdgcn_fence(__ATOMIC_ACQUIRE, "agent");
            asm volatile("s_waitcnt vmcnt(0)" ::: "memory");
        }
    }
    __syncthreads();
}

struct Args { const float* in[31]; float* out; unsigned char* ws; };
struct Frame {
    LAS unsigned char* lds;
    int tid, lane, wave, vcu, G, gw, NGW, bx;
    unsigned char* ws;
};

__device__ __forceinline__ void transpose_item64(const float* W, int ld, bf16_t* WT, int k0, int n0, int c0, int nvalid, int lane) {
    const bool ok = lane < nvalid; const int col = (c0 + lane < ld) ? c0 + lane : ld - 1;
    const float* src = W + (size_t)k0 * ld + col;
    float v[64];
#pragma unroll
    for (int i = 0; i < 64; ++i) { v[i] = *src; src += ld; }
    if (!__all(ok)) {
#pragma unroll
        for (int i = 0; i < 64; ++i) v[i] = ok ? v[i] : 0.f;
    }
    u32x4* dst = (u32x4*)(WT + (size_t)(n0 + lane) * 1024 + k0);
#pragma unroll
    for (int j = 0; j < 8; ++j) { u32x4 o; o.x = pk2(v[8 * j], v[8 * j + 1]); o.y = pk2(v[8 * j + 2], v[8 * j + 3]); o.z = pk2(v[8 * j + 4], v[8 * j + 5]); o.w = pk2(v[8 * j + 6], v[8 * j + 7]); dst[j] = o; }
}
struct ConvJob { const float* w_in; int nin, npad; const float* w_out; const float* w_gu; const float* w_dn; size_t woff; };
__device__ __forceinline__ int conv_nitems(const ConvJob& J) { return 16 * (J.npad / 64) + 16 * 16 + NE * 16 * 32 + NE * 16 * 16; }
__device__ __forceinline__ void convert_item(const Frame& F, const ConvJob& J, int it) {
    bf16_t* WIN = (bf16_t*)(F.ws + J.woff + WS_WIN); bf16_t* WOUT = (bf16_t*)(F.ws + J.woff + WS_WOUT); bf16_t* WGU = (bf16_t*)(F.ws + J.woff + WS_WGU); bf16_t* WDN = (bf16_t*)(F.ws + J.woff + WS_WDN);
    const int I_IN = 16 * (J.npad / 64), I_OUT = 16 * 16, I_GU = NE * 16 * 32;
    const int lane = fresh_lane();
    int r = it;
    if (r < I_IN) { const int nblk = J.npad / 64, kb = r / nblk, nb = r % nblk; const int c0 = nb * 64; int nv = J.nin - c0; nv = nv < 0 ? 0 : (nv > 64 ? 64 : nv);
        transpose_item64(J.w_in, J.nin, WIN, kb * 64, nb * 64, c0, nv, lane); return; }
    r -= I_IN;
    if (r < I_OUT) { const int kb = r / 16, nb = r % 16; transpose_item64(J.w_out, D_, WOUT, kb * 64, nb * 64, nb * 64, 64, lane); return; }
    r -= I_OUT;
    if (r < I_GU) { const int e = r / (16 * 32), rr = r % (16 * 32), kb = rr / 32, nb = rr % 32; const int rho = nb * 64;
        const int pn = rho >> 8, bj = (rho >> 7) & 1, j = rho & 127; const int c0 = bj * DFF + pn * 128 + j;
        transpose_item64(J.w_gu + (size_t)e * D_ * 2 * DFF, 2 * DFF, WGU + (size_t)e * 2 * DFF * D_, kb * 64, rho, c0, 64, lane); return; }
    r -= I_GU;
    { const int e = r / (16 * 16), rr = r % (16 * 16), kb = rr / 16, nb = rr % 16;
        transpose_item64(J.w_dn + (size_t)e * DFF * D_, D_, WDN + (size_t)e * D_ * DFF, kb * 64, nb * 64, nb * 64, 64, lane); }
}
struct ConvAddr { const float* src; size_t ld; bf16_t* dst; bool ok; };
__device__ __forceinline__ ConvAddr conv_addr(const Frame& F, const ConvJob& J, int it, int lane) {
    bf16_t* WIN = (bf16_t*)(F.ws + J.woff + WS_WIN); bf16_t* WOUT = (bf16_t*)(F.ws + J.woff + WS_WOUT); bf16_t* WGU = (bf16_t*)(F.ws + J.woff + WS_WGU); bf16_t* WDN = (bf16_t*)(F.ws + J.woff + WS_WDN);
    const int I_IN = 16 * (J.npad / 64), I_OUT = 16 * 16, I_GU = NE * 16 * 32;
    ConvAddr a; int r = it;
    if (r < I_IN) { const int nblk = J.npad / 64, kb = r / nblk, nb = r % nblk; const int c0 = nb * 64; int nv = J.nin - c0; nv = nv < 0 ? 0 : (nv > 64 ? 64 : nv);
        a.src = J.w_in + (size_t)(kb * 64) * J.nin + ((c0 + lane < J.nin) ? c0 + lane : J.nin - 1); a.ld = J.nin;         a.dst = WIN + (size_t)(nb * 64 + lane) * 1024 + kb * 64; a.ok = lane < nv; return a; }
    r -= I_IN;
    if (r < I_OUT) { const int kb = r / 16, nb = r % 16; a.src = J.w_out + (size_t)(kb * 64) * D_ + nb * 64 + lane; a.ld = D_; a.dst = WOUT + (size_t)(nb * 64 + lane) * 1024 + kb * 64; a.ok = true; return a; }
    r -= I_OUT;
    if (r < I_GU) { const int e = r / (16 * 32), rr = r % (16 * 32), kb = rr / 32, nb = rr % 32; const int rho = nb * 64;
        const int pn = rho >> 8, bj = (rho >> 7) & 1, j = rho & 127; const int c0 = bj * DFF + pn * 128 + j;
        a.src = J.w_gu + (size_t)e * D_ * 2 * DFF + (size_t)(kb * 64) * (2 * DFF) + c0 + lane; a.ld = 2 * DFF; a.dst = WGU + (size_t)e * 2 * DFF * D_ + (size_t)(rho + lane) * 1024 + kb * 64; a.ok = true; return a; }
    r -= I_GU;
    { const int e = r / (16 * 16), rr = r % (16 * 16), kb = rr / 16, nb = rr % 16;
      a.src = J.w_dn + (size_t)e * DFF * D_ + (size_t)(kb * 64) * D_ + nb * 64 + lane; a.ld = D_; a.dst = WDN + (size_t)e * D_ * DFF + (size_t)(nb * 64 + lane) * 1024 + kb * 64; a.ok = true; return a; }
}
__device__ __forceinline__ void conv_load(const ConvAddr& a, float (&v)[64]) {
    const float* p = a.src; const size_t ld = a.ld;
#pragma unroll
    for (int i = 0; i < 64; ++i) { v[i] = *p; p += ld; }
    if (!__all(a.ok)) {
#pragma unroll
        for (int i = 0; i < 64; ++i) v[i] = a.ok ? v[i] : 0.f;
    }
}
__device__ __forceinline__ void conv_store(const ConvAddr& a, const float (&v)[64]) {
    u32x4* dst = (u32x4*)a.dst;
#pragma unroll
    for (int j = 0; j < 8; ++j) { u32x4 o; o.x = pk2(v[8 * j], v[8 * j + 1]); o.y = pk2(v[8 * j + 2], v[8 * j + 3]); o.z = pk2(v[8 * j + 4], v[8 * j + 5]); o.w = pk2(v[8 * j + 6], v[8 * j + 7]); dst[j] = o; }
}
__device__ __forceinline__ void convert_weights(const Frame& F, const ConvJob& J, int nfirst) {
    for (int it = F.gw; it < nfirst; it += F.NGW) convert_item(F, J, it);
}
__device__ __forceinline__ void convert_queue(const Frame& F, const ConvJob& J, int* ctr, int max_batches, const int per_wave = 1, const int item0 = 0) {
    volatile LAS int* word = (volatile LAS int*)(F.lds + MISC_OFF + 64);
    const int n = conv_nitems(J);
    for (int b = 0; b < max_batches; ++b) {
        __syncthreads();
        if (F.tid == 0) *word = atomicAdd(ctr, NWAVES * per_wave);
        __syncthreads();
        const int base = *word;
        if (item0 + base >= n) break;
        for (int k = 0; k < per_wave; ++k) { const int it = item0 + base + k * NWAVES + F.wave; if (it < n) convert_item(F, J, it); }
    }
    __syncthreads();
}
__device__ __forceinline__ void convert_x(const Frame& F, const float* x, bf16_t* xb) {
    for (int m = F.gw; m < NTOK; m += F.NGW) {
        const f32x4* xr = (const f32x4*)(x + (size_t)m * D_) + F.lane; u32x2* o = (u32x2*)(xb + (size_t)m * D_) + F.lane;
#pragma unroll
        for (int j = 0; j < 4; ++j) { const f32x4 v = xr[64 * j]; u32x2 w; w.x = pk2(v[0], v[1]); w.y = pk2(v[2], v[3]); o[64 * j] = w; }
    }
}

__device__ __forceinline__ float key2f(unsigned k) { return __uint_as_float((k & 0x80000000u) ? (k ^ 0x80000000u) : ~k); }
__device__ __forceinline__ unsigned f2key(float f) { unsigned b = __float_as_uint(f); return b ^ ((b >> 31) ? 0xFFFFFFFFu : 0x80000000u); }

__device__ __forceinline__ void conv_phase(const Frame& F, const bf16_t* H, const float* cw, bf16_t* Y) {
    for (int idx = (F.vcu * NTHR + F.tid); idx < NTOK * 64; idx += F.G * NTHR) {
        const int tok = idx >> 6, c = (idx & 63) * 8, t = tok & (S_ - 1);
        const bf16_t* h = H + (size_t)tok * EVEN_PAD;
        float y[8] = {0.f, 0.f, 0.f, 0.f, 0.f, 0.f, 0.f, 0.f};
#pragma unroll
        for (int j = 0; j < 3; ++j) if (t >= j) { const bf16_t* hj = h - (size_t)j * EVEN_PAD; const u32x4 gc = *(const u32x4*)(hj + E_GC + c), xa = *(const u32x4*)(hj + E_XA + c);
            const f32x4 w0 = *(const f32x4*)(cw + j * 512 + c), w1 = *(const f32x4*)(cw + j * 512 + c + 4);
            y[0] += w0[0] * (bflo(gc.x) * bflo(xa.x)); y[1] += w0[1] * (bfhi(gc.x) * bfhi(xa.x)); y[2] += w0[2] * (bflo(gc.y) * bflo(xa.y)); y[3] += w0[3] * (bfhi(gc.y) * bfhi(xa.y));
            y[4] += w1[0] * (bflo(gc.z) * bflo(xa.z)); y[5] += w1[1] * (bfhi(gc.z) * bfhi(xa.z)); y[6] += w1[2] * (bflo(gc.w) * bflo(xa.w)); y[7] += w1[3] * (bfhi(gc.w) * bfhi(xa.w)); }
        const u32x4 gb = *(const u32x4*)(h + E_GB + c);
        u32x4 o; o.x = pk2(bflo(gb.x) * y[0], bfhi(gb.x) * y[1]); o.y = pk2(bflo(gb.y) * y[2], bfhi(gb.y) * y[3]); o.z = pk2(bflo(gb.z) * y[4], bfhi(gb.z) * y[5]); o.w = pk2(bflo(gb.w) * y[6], bfhi(gb.w) * y[7]);
        *(u32x4*)(Y + (size_t)tok * D_ + c) = o;
    }
}

__device__ __forceinline__ void dsa_select_phase(const Frame& F, const bf16_t* H, unsigned long long* MASK, const ConvJob& CJ, int* cctr, const int citem0) {
    typedef float f32x16 __attribute__((ext_vector_type(16)));
    LAS float* sc = (LAS float*)F.lds;
    const int lane = F.lane, wid = F.wave, c = lane & 31, hi = lane >> 5;
    const int rho = lane & 31, ah = (rho & 3) + 4 * ((rho >> 3) & 1), at = ((rho >> 2) & 1) + 2 * (rho >> 4);
    int cbase1 = -1;
    for (int itp = F.vcu; itp < 1024; itp += F.G) {
        const int bb = itp >> 8, vv = itp & 255;
        for (int pp = 0; pp < 2; ++pp) {
            const int p = pp ? 511 - vv : vv;
            const int tq0 = 8 * p, tmax = tq0 + 7, ntile = (tmax >> 5) + 1;
            if (F.tid == 0) *(volatile LAS int*)(F.lds + MISC_OFF + 64) = atomicAdd(cctr, 2 * NWAVES);
            const size_t row0 = (size_t)bb * S_ + tq0;
            bf16x8 af[2][2]; float wq[2][16];
#pragma unroll
            for (int g = 0; g < 2; ++g) {
                const bf16_t* qrow = H + (row0 + 4 * g + at) * EVEN_PAD + E_IQ + ah * 32 + 8 * hi;
                af[g][0] = *(const bf16x8*)qrow; af[g][1] = *(const bf16x8*)(qrow + 16);
#pragma unroll
                for (int q2 = 0; q2 < 2; ++q2) { const u32x4 w = *(const u32x4*)(H + (row0 + 4 * g + hi + 2 * q2) * EVEN_PAD + E_IW);
                    wq[g][8 * q2 + 0] = bflo(w.x); wq[g][8 * q2 + 1] = bfhi(w.x); wq[g][8 * q2 + 2] = bflo(w.y); wq[g][8 * q2 + 3] = bfhi(w.y);
                    wq[g][8 * q2 + 4] = bflo(w.z); wq[g][8 * q2 + 5] = bfhi(w.z); wq[g][8 * q2 + 6] = bflo(w.w); wq[g][8 * q2 + 7] = bfhi(w.w); }
            }
#define SEL_LOAD(BQ, tb_) do { _Pragma("unroll") for (int q4 = 0; q4 < 4; ++q4) { int tile = (tb_) + q4 * NWAVES; tile = tile < ntile ? tile : ntile - 1; \
                    const bf16_t* krow = H + ((size_t)bb * S_ + 32 * tile + c) * EVEN_PAD + E_IK + 8 * hi; \
                    BQ[q4][0] = *(const bf16x8*)krow; BQ[q4][1] = *(const bf16x8*)(krow + 16); } } while (0)
#define SEL_COMP(BQ, tb_) do { _Pragma("unroll") for (int q4 = 0; q4 < 4; ++q4) { const int tile = (tb_) + q4 * NWAVES; \
                    if (tile < ntile) { const int key = 32 * tile + c; \
                        _Pragma("unroll") for (int g = 0; g < 2; ++g) { \
                            f32x16 d = {0.f, 0.f, 0.f, 0.f, 0.f, 0.f, 0.f, 0.f, 0.f, 0.f, 0.f, 0.f, 0.f, 0.f, 0.f, 0.f}; \
                            d = __builtin_amdgcn_mfma_f32_32x32x16_bf16(af[g][0], BQ[q4][0], d, 0, 0, 0); \
                            d = __builtin_amdgcn_mfma_f32_32x32x16_bf16(af[g][1], BQ[q4][1], d, 0, 0, 0); \
                            float s0 = 0.f, s1 = 0.f; \
                            _Pragma("unroll") for (int r = 0; r < 8; ++r) { s0 += wq[g][r] * fmaxf(d[r], 0.f); s1 += wq[g][8 + r] * fmaxf(d[8 + r], 0.f); } \
                            sc[(4 * g + hi) * S_ + key] = s0; sc[(4 * g + hi + 2) * S_ + key] = s1; } } } } while (0)
            {
                const int cit1 = cbase1 >= 0 ? citem0 + cbase1 + NWAVES + wid : 0x7fffffff; const bool chas1 = cit1 < conv_nitems(CJ);
                ConvAddr ca1; float cv1[64];
                if (chas1) { ca1 = conv_addr(F, CJ, cit1, fresh_lane()); conv_load(ca1, cv1); }
                bf16x8 bqA[4][2];
                for (int tb = wid; tb < ntile; tb += 4 * NWAVES) { SEL_LOAD(bqA, tb); SEL_COMP(bqA, tb); }
                if (chas1) conv_store(ca1, cv1);
            }
#undef SEL_LOAD
#undef SEL_COMP
            __syncthreads();
            {
                const int lane2 = fresh_lane();
                const int t = tq0 + wid, n = t + 1;
                cbase1 = *(volatile LAS int*)(F.lds + MISC_OFF + 64);
                const int cit = citem0 + cbase1 + wid; const bool chas = cit < conv_nitems(CJ);
                ConvAddr ca; float cv[64];
                if (chas) { ca = conv_addr(F, CJ, cit, lane2); conv_load(ca, cv); }
                unsigned long long myword = 0ull;
                if (n <= 256) {
                    const int k0 = 64 * lane2;
                    myword = (k0 + 63 <= t) ? ~0ull : (k0 > t) ? 0ull : ((1ull << (t - k0 + 1)) - 1ull);
                } else {
                    const LAS float* scr = sc + wid * S_;
                    float u[64];
                    const int nreg = (n + 63) >> 6, nfull = n >> 6;
#pragma unroll
                    for (int ch = 0; ch < 4; ++ch) {
                        if (nfull >= 16 * ch + 16) {
#pragma unroll
                            for (int i = 16 * ch; i < 16 * ch + 16; ++i) u[i] = scr[64 * i + lane2];
                        } else if (nreg > 16 * ch) {
#pragma unroll
                            for (int i = 16 * ch; i < 16 * ch + 16; ++i) { const int s_ = 64 * i + lane2; const float v = scr[s_]; u[i] = (s_ <= t) ? v : -INFINITY; }
                        } else {
#pragma unroll
                            for (int i = 16 * ch; i < 16 * ch + 16; ++i) u[i] = -INFINITY;
                        }
                    }
                    unsigned T = 0u; bool exact = false;
#pragma unroll 1
                    for (int bit = 31; bit >= 0; --bit) {
                        const unsigned candk = T | (1u << bit); const float cand = key2f(candk); int c0_ = 0, c1_ = 0, c2_ = 0, c3_ = 0;
#pragma unroll
                        for (int ch = 0; ch < 4; ++ch) if (nreg > 16 * ch) {
#pragma unroll
                            for (int i = 0; i < 16; i += 4) { c0_ += (u[16 * ch + i] >= cand) ? 1 : 0; c1_ += (u[16 * ch + i + 1] >= cand) ? 1 : 0; c2_ += (u[16 * ch + i + 2] >= cand) ? 1 : 0; c3_ += (u[16 * ch + i + 3] >= cand) ? 1 : 0; } }
                        const int cl = wave_sum_iu((c0_ + c1_) + (c2_ + c3_));
                        if (cl >= 256) T = candk;
                        if (cl == 256) { exact = true; break; }
                    }
                    if (exact) {
                        float T3; { int tv = (int)T; asm volatile("" : "+v"(tv)); T3 = key2f((unsigned)__builtin_amdgcn_readfirstlane(tv)); }
#pragma unroll
                        for (int ch = 0; ch < 4; ++ch) if (nreg > 16 * ch) {
#pragma unroll
                            for (int i = 16 * ch; i < 16 * ch + 16; ++i) { const unsigned long long w = __ballot(u[i] >= T3); if (lane2 == i) myword = w; if ((i & 3) == 3) __builtin_amdgcn_sched_barrier(0); } }
                    } else {
                    int ngt = 0;
                    const float Tf = key2f(T);
#pragma unroll
                    for (int i = 0; i < 64; ++i) { ngt += __popcll(__ballot(u[i] > Tf)); if ((i & 3) == 3) __builtin_amdgcn_sched_barrier(0); }
                    int need = 256 - ngt;
                    float T2; { int tv = (int)T; asm volatile("" : "+v"(tv)); T2 = key2f((unsigned)__builtin_amdgcn_readfirstlane(tv)); }
                    int base = 0;
#pragma unroll
                    for (int i = 0; i < 64; ++i) {
                        const bool gtb = u[i] > T2, eqb = u[i] == T2;
                        const unsigned long long eq = __ballot(eqb);
                        const int rk = base + (int)__builtin_amdgcn_mbcnt_hi((unsigned)(eq >> 32), __builtin_amdgcn_mbcnt_lo((unsigned)eq, 0u));
                        const unsigned long long w = __ballot(gtb || (eqb && rk < need));
                        base += __popcll(eq);
                        if (lane2 == i) myword = w;
                        __builtin_amdgcn_sched_barrier(0);
                    }
                    }
                }
                MASK[(row0 + wid) * 64 + lane2] = myword;
                if (chas) conv_store(ca, cv);
            }
            __syncthreads();
        }
    }
    if (cbase1 >= 0) { const int citl = citem0 + cbase1 + NWAVES + wid; if (citl < conv_nitems(CJ)) convert_item(F, CJ, citl); }
}

namespace att {
typedef float f32x16 __attribute__((ext_vector_type(16)));
typedef short s16x4 __attribute__((ext_vector_type(4)));
constexpr int NW = 8, QBLK = 32, QB = 256, KVBLK = 64;
constexpr float C2 = 0.125f * 1.4426950408889634f;
constexpr float LOG2E = 1.4426950408889634f;
constexpr int SLOTB = 8192, LDS_K = 0, LDS_V = 3 * SLOTB, LDS_WS = 6 * SLOTB, LDS_OST = LDS_WS + NW * 256, LDS_ATT_BYTES = LDS_OST + NW * 4096;
constexpr int THR = 8;
#define SBAR() __builtin_amdgcn_sched_barrier(0)
#define PIN(x) asm volatile("" : "+v"(x))
#define MFMA(a, b, c) __builtin_amdgcn_mfma_f32_32x32x16_bf16(a, b, c, 0, 0, 0)
#define WAIT_BAR(N) asm volatile("s_waitcnt vmcnt(" #N ") lgkmcnt(0)\n\ts_barrier" ::: "memory")
__device__ __forceinline__ int crow(int r, int hi) { return (r & 3) + 8 * (r >> 2) + 4 * hi; }
__device__ __forceinline__ unsigned cvtpk(float lo, float hi) { unsigned r; asm("v_cvt_pk_bf16_f32 %0, %1, %2" : "=v"(r) : "v"(lo), "v"(hi)); return r; }
__device__ __forceinline__ void glds16(const void* g, unsigned lds_base) {
    unsigned sv; asm volatile("s_mov_b32 %0, m0\n\ts_mov_b32 m0, %2\n\ts_nop 0\n\tglobal_load_lds_dwordx4 %1, off\n\ts_mov_b32 m0, %0" : "=&s"(sv) : "v"(g), "s"(lds_base) : "memory"); }
typedef __attribute__((address_space(3))) const char* lds_cptr;
typedef short v4i16_t __attribute__((ext_vector_type(4)));
__device__ __forceinline__ void kload2(bf16x8* kf, lds_cptr kp, int d0) { kf[2 * d0] = *(const __attribute__((address_space(3))) bf16x8*)(kp + d0 * 2048); kf[2 * d0 + 1] = *(const __attribute__((address_space(3))) bf16x8*)(kp + d0 * 2048 + 512); }
__device__ __forceinline__ s16x4 vtr(lds_cptr p) { return __builtin_bit_cast(s16x4, __builtin_amdgcn_ds_read_tr16_b64_v4i16((__attribute__((address_space(3))) v4i16_t*)p)); }
#define MX3(a, b, c) __builtin_fmaxf(__builtin_fmaxf((a), (b)), (c))
__device__ __forceinline__ float max16(const f32x16& p) {
    float a = MX3(p[0], p[1], p[2]), b = MX3(p[3], p[4], p[5]); a = MX3(a, p[6], p[7]); b = MX3(b, p[8], p[9]); a = MX3(a, p[10], p[11]); b = MX3(b, p[12], p[13]); a = MX3(a, p[14], p[15]);
    return __builtin_fmaxf(a, b); }
__device__ __forceinline__ float halfmax(float m) { auto rr = __builtin_amdgcn_permlane32_swap(__float_as_uint(m), __float_as_uint(m), false, false); return __builtin_fmaxf(__uint_as_float(rr[0]), __uint_as_float(rr[1])); }
__device__ __forceinline__ void cmask(f32x16& p0, f32x16& p1, int jb, int qrel, int hi) {
    const int kb = 64 * jb + 4 * hi;
#pragma unroll
    for (int r = 0; r < 16; ++r) { const int kv = kb + (r & 3) + 8 * (r >> 2); if (kv > qrel) p0[r] = -INFINITY; if (kv + 32 > qrel) p1[r] = -INFINITY; } }
__device__ __forceinline__ void wmask(f32x16& p0, f32x16& p1, unsigned lo, unsigned hw, int hi) {
    lo >>= 4 * hi; hw >>= 4 * hi;
#pragma unroll
    for (int r = 0; r < 16; ++r) { const int cr = (r & 3) + 8 * (r >> 2);
        const unsigned m0 = (unsigned)((int)(lo << (31 - cr)) >> 31), m1 = (unsigned)((int)(hw << (31 - cr)) >> 31);
        p0[r] = __uint_as_float((__float_as_uint(p0[r]) & m0) | (0xff800000u & ~m0)); p1[r] = __uint_as_float((__float_as_uint(p1[r]) & m1) | (0xff800000u & ~m1)); } }

template <int MODE>
__device__ __forceinline__ void attn_unit(const bf16_t* Qh, const bf16_t* Kh, const bf16_t* Vh, bf16_t* Oh, const int QP, const int KP, const int VP, const int OP,
                                          const int rowbase, const int qb, const float sl2, const unsigned long long* maskp, char* lds, const int tid) {
    const int lane = tid & 63, r32 = lane & 31, hi = lane >> 5; const int wid = __builtin_amdgcn_readfirstlane(tid >> 6);
    const int q0 = qb * QB, NT = (q0 + QB) / KVBLK;
    const bf16_t* Qw = Qh + (size_t)(rowbase + q0 + wid * QBLK) * QP;
    const unsigned lds0 = (unsigned)(uintptr_t)lds; float* wsf = (float*)(lds + LDS_WS) + wid * 64;
    const bf16_t* ksrc = Kh + (size_t)rowbase * KP + (size_t)lane * KP + wid * 8;
    const bf16_t* vsrc = Vh + (size_t)rowbase * VP + (size_t)(16 * (wid & 3) + (lane >> 2)) * VP + (wid >> 2) * 32 + (lane & 3) * 8;
    const unsigned kdst = lds0 + LDS_K + wid * 1024, vdst = lds0 + LDS_V + wid * 1024;
#define DMA_K(t, slot) glds16(ksrc + (size_t)(NT - 1 - (t)) * KVBLK * KP, (unsigned)__builtin_amdgcn_readfirstlane(kdst + (slot)))
#define DMA_V(t, slot) glds16(vsrc + (size_t)(NT - 1 - (t)) * KVBLK * VP, (unsigned)__builtin_amdgcn_readfirstlane(vdst + (slot)))
    const lds_cptr vp0 = (lds_cptr)lds + LDS_V + ((lane >> 4) & 1) * 32 + (lane & 3) * 8 + (4 * hi + ((lane & 15) >> 2)) * 64;
    const lds_cptr kp0 = (lds_cptr)lds + LDS_K + hi * 1024 + r32 * 16;
    DMA_K(0, 0); DMA_V(0, 0); DMA_K(1, SLOTB);
    bf16x8 qr[4];
#pragma unroll
    for (int d0 = 0; d0 < 4; ++d0) qr[d0] = *reinterpret_cast<const bf16x8*>(&Qw[(size_t)r32 * QP + d0 * 16 + hi * 8]);
    const int qrel = wid * QBLK + r32;
    const unsigned moff = (unsigned)qrel * 512u;
    unsigned long long mw = 0ull;
    if (MODE == 1) mw = *(const unsigned long long*)((const char*)maskp + (moff + 8u * (unsigned)(NT - 1)));
    float mhat = 0.f, l_reg = 0.f; f32x16 o[2]; o[0] = f32x16{}; o[1] = f32x16{};
    f32x16 bz;
#pragma unroll
    for (int r = 0; r < 16; ++r) bz[r] = sl2 * (float)((r & 3) + 8 * (r >> 2) + 4 * hi - 255) * (1.0f / C2);
    PIN(bz);
    bool resc = false;
    f32x16 pA0, pA1, pB0, pB1; bf16x8 kf[8]; s16x4 vlo[8], vhi[8]; u32x4 pw0, pw1, pw2, pw3;
    int sl_prev = 0, sl_cur = 0, sl_next = SLOTB;
#define ROT() do { sl_prev = sl_cur; sl_cur = sl_next; sl_next = (sl_next == 2 * SLOTB) ? 0 : sl_next + SLOTB; } while (0)
#define EX0(v) __builtin_amdgcn_exp2f(__builtin_fmaf((v), C2, nmh0))
#define EX1(v) __builtin_amdgcn_exp2f(__builtin_fmaf((v), C2, nmh1))
#define BT0(t) (sl2 * (float)(64 * (3 - (t))))
#define RESC() do { if (resc) { _Pragma("unroll") for (int d_ = 0; d_ < 2; ++d_) _Pragma("unroll") for (int r = 0; r < 16; ++r) o[d_][r] *= wsf[crow(r, hi)]; } } while (0)
    DMA_K(2, 2 * SLOTB);
    WAIT_BAR(3);
    _Pragma("unroll") for (int d0 = 0; d0 < 4; ++d0) kload2(kf, kp0, d0);
    pA0 = MFMA(kf[0], qr[0], bz); pA1 = MFMA(kf[1], qr[0], bz); pA0 = MFMA(kf[2], qr[1], pA0); pA1 = MFMA(kf[3], qr[1], pA1);
    pA0 = MFMA(kf[4], qr[2], pA0); pA1 = MFMA(kf[5], qr[2], pA1); pA0 = MFMA(kf[6], qr[3], pA0); pA1 = MFMA(kf[7], qr[3], pA1);
    if (MODE == 0) cmask(pA0, pA1, 3, qrel, hi); else wmask(pA0, pA1, (unsigned)mw, (unsigned)(mw >> 32), hi);
    { const float b0 = BT0(0), b1 = b0 + 32.f * sl2;
      const float rm = halfmax(__builtin_fmaxf(__builtin_fmaf(max16(pA0), C2, b0), __builtin_fmaf(max16(pA1), C2, b1)));
      mhat = __builtin_fmaxf(rm, -1e30f); const float nmh0 = b0 - mhat, nmh1 = b1 - mhat;
#pragma unroll
      for (int r = 0; r < 16; ++r) { pA0[r] = EX0(pA0[r]); pA1[r] = EX1(pA1[r]); } }
    WAIT_BAR(0);
    DMA_K(3, 0); DMA_V(1, SLOTB); ROT();
    _Pragma("unroll") for (int d0 = 0; d0 < 4; ++d0) kload2(kf, kp0 + sl_cur, d0);
    WAIT_BAR(2);
#define PKW(P, i) cvtpk(P[i], P[i + 1])
#define PAF(k) __builtin_bit_cast(bf16x8, pw##k)
#define VFR(i) (bf16x8){vlo[i][0], vlo[i][1], vlo[i][2], vlo[i][3], vhi[i][0], vhi[i][1], vhi[i][2], vhi[i][3]}
#define VRD(i) do { vlo[i] = vtr(vp_ + (((i) >> 2) * 4096 + ((i) & 3) * 1024)); vhi[i] = vtr(vp_ + (((i) >> 2) * 4096 + ((i) & 3) * 1024 + 512)); } while (0)
#define KRD(G, d0) do { if (G) { kload2(kf, kp0 + sl_next, d0); SBAR(); } } while (0)
#define GAPA(MF, a0, a1, a2, a3, W0, W1, PW) do { MF; sacc += a0; sacc += a1; sacc += a2; sacc += a3; W0; W1; PIN(PW); PIN(sacc); SBAR(); } while (0)
#define GAPB0(MF, X, i) do { MF; X[i] = EX0(X[i]); X[i + 1] = EX0(X[i + 1]); X[i + 2] = EX0(X[i + 2]); X[i + 3] = EX0(X[i + 3]); PIN(X); SBAR(); } while (0)
#define GAPB1(MF, X, i) do { MF; X[i] = EX1(X[i]); X[i + 1] = EX1(X[i + 1]); X[i + 2] = EX1(X[i + 2]); X[i + 3] = EX1(X[i + 3]); PIN(X); SBAR(); } while (0)
#define STEP(C0, C1, P0, P1, t, MASK, GK, GV, GL) do { SBAR(); \
    const lds_cptr vp_ = vp0 + sl_prev; \
    if (MODE == 1) mw = *(const unsigned long long*)((const char*)maskp + (moff + 8u * (unsigned)(NT - 1 - (t)))); \
    VRD(0); SBAR(); float sacc = P0[0] + P0[1]; \
                    GAPA(C0 = MFMA(kf[0], qr[0], bz), P0[2], P0[3], P0[4], P0[5],     pw0[0] = PKW(P0, 0),  pw0[1] = PKW(P0, 2),  pw0); \
    VRD(4); SBAR(); GAPA(C1 = MFMA(kf[1], qr[0], bz), P0[6], P0[7], P0[8], P0[9],     pw0[2] = PKW(P0, 4),  pw0[3] = PKW(P0, 6),  pw0); \
    VRD(1); SBAR(); GAPA(C0 = MFMA(kf[2], qr[1], C0),    P0[10], P0[11], P0[12], P0[13], pw1[0] = PKW(P0, 8),  pw1[1] = PKW(P0, 10), pw1); \
    VRD(5); SBAR(); GAPA(C1 = MFMA(kf[3], qr[1], C1),    P0[14], P0[15], P1[0], P1[1],   pw1[2] = PKW(P0, 12), pw1[3] = PKW(P0, 14), pw1); \
    VRD(2); SBAR(); GAPA(C0 = MFMA(kf[4], qr[2], C0),    P1[2], P1[3], P1[4], P1[5],     pw2[0] = PKW(P1, 0),  pw2[1] = PKW(P1, 2),  pw2); \
    VRD(6); SBAR(); GAPA(C1 = MFMA(kf[5], qr[2], C1),    P1[6], P1[7], P1[8], P1[9],     pw2[2] = PKW(P1, 4),  pw2[3] = PKW(P1, 6),  pw2); \
    VRD(3); SBAR(); GAPA(C0 = MFMA(kf[6], qr[3], C0),    P1[10], P1[11], P1[12], P1[13], pw3[0] = PKW(P1, 8),  pw3[1] = PKW(P1, 10), pw3); \
    VRD(7); SBAR(); GAPA(C1 = MFMA(kf[7], qr[3], C1),    P1[14], P1[15], 0.f, 0.f,       pw3[2] = PKW(P1, 12), pw3[3] = PKW(P1, 14), pw3); \
    l_reg += sacc; \
    if (MODE == 1) wmask(C0, C1, (unsigned)mw, (unsigned)(mw >> 32), hi); \
    if (GK) DMA_K((t) + 3, sl_cur); if (GV) DMA_V((t) + 1, sl_next); \
    if (MODE == 0) { if (MASK) cmask(C0, C1, 3 - (t), qrel, hi); } \
    const float b0_ = BT0(t), b1_ = b0_ + 32.f * sl2; \
    { const float rma = halfmax(__builtin_fmaxf(__builtin_fmaf(max16(C0), C2, b0_), __builtin_fmaf(max16(C1), C2, b1_))); resc = false;     \
      if (__builtin_expect(__any(rma - mhat > (float)THR), 0)) { const float mn_ = __builtin_fmaxf(mhat, rma); \
          const float f = __builtin_amdgcn_exp2f(mhat - mn_); mhat = mn_; l_reg *= f; if (hi == 0) wsf[r32] = f; resc = true; } } \
    const float nmh0 = b0_ - mhat, nmh1 = b1_ - mhat; SBAR(); \
    GAPB0(o[0] = MFMA(PAF(0), VFR(0), o[0]), C0, 0);              GAPB0(o[1] = MFMA(PAF(0), VFR(4), o[1]), C0, 4); \
    KRD(GL, 0); GAPB0(o[0] = MFMA(PAF(1), VFR(1), o[0]), C0, 8);  KRD(GL, 1); GAPB0(o[1] = MFMA(PAF(1), VFR(5), o[1]), C0, 12); \
    KRD(GL, 2); GAPB1(o[0] = MFMA(PAF(2), VFR(2), o[0]), C1, 0);  KRD(GL, 3); GAPB1(o[1] = MFMA(PAF(2), VFR(6), o[1]), C1, 4); \
    GAPB1(o[0] = MFMA(PAF(3), VFR(3), o[0]), C1, 8);              GAPB1(o[1] = MFMA(PAF(3), VFR(7), o[1]), C1, 12); \
    } while (0)
#define ENDW(tt) do { if ((tt) + 3 < NT) { WAIT_BAR(2); } else if ((tt) + 2 < NT) { WAIT_BAR(1); } else { WAIT_BAR(0); } } while (0)
    int t = 1;
    for (; t <= 3 && t + 1 < NT; t += 2) {
        STEP(pB0, pB1, pA0, pA1, t, (t <= 3), (t + 3 < NT), (t + 1 < NT), (t + 1 < NT));             ENDW(t);     RESC(); ROT();
        STEP(pA0, pA1, pB0, pB1, t + 1, (t + 1 <= 3), (t + 4 < NT), (t + 2 < NT), (t + 2 < NT));     ENDW(t + 1); RESC(); ROT();
    }
    for (; t + 5 < NT; t += 2) {
        STEP(pB0, pB1, pA0, pA1, t, false, true, true, true);     WAIT_BAR(2); RESC(); ROT();
        STEP(pA0, pA1, pB0, pB1, t + 1, false, true, true, true); WAIT_BAR(2); RESC(); ROT();
    }
    for (; t + 1 < NT; t += 2) {
        STEP(pB0, pB1, pA0, pA1, t, (t <= 3), (t + 3 < NT), (t + 1 < NT), (t + 1 < NT));             ENDW(t);     RESC(); ROT();
        STEP(pA0, pA1, pB0, pB1, t + 1, (t + 1 <= 3), (t + 4 < NT), (t + 2 < NT), (t + 2 < NT));     ENDW(t + 1); RESC(); ROT();
    }
    STEP(pB0, pB1, pA0, pA1, NT - 1, (NT - 1 <= 3), false, false, false); RESC();
    { float sacc = pB0[0] + pB0[1];
#pragma unroll
      for (int r = 2; r < 16; ++r) sacc += pB0[r];
#pragma unroll
      for (int r = 0; r < 16; ++r) sacc += pB1[r];
      l_reg += sacc;
      pw0 = (u32x4){PKW(pB0, 0), PKW(pB0, 2), PKW(pB0, 4), PKW(pB0, 6)}; pw1 = (u32x4){PKW(pB0, 8), PKW(pB0, 10), PKW(pB0, 12), PKW(pB0, 14)};
      pw2 = (u32x4){PKW(pB1, 0), PKW(pB1, 2), PKW(pB1, 4), PKW(pB1, 6)}; pw3 = (u32x4){PKW(pB1, 8), PKW(pB1, 10), PKW(pB1, 12), PKW(pB1, 14)};
      const lds_cptr vp_ = vp0 + sl_cur; _Pragma("unroll") for (int i = 0; i < 8; ++i) VRD(i);
      o[0] = MFMA(PAF(0), VFR(0), o[0]); o[1] = MFMA(PAF(0), VFR(4), o[1]); o[0] = MFMA(PAF(1), VFR(1), o[0]); o[1] = MFMA(PAF(1), VFR(5), o[1]);
      o[0] = MFMA(PAF(2), VFR(2), o[0]); o[1] = MFMA(PAF(2), VFR(6), o[1]); o[0] = MFMA(PAF(3), VFR(3), o[0]); o[1] = MFMA(PAF(3), VFR(7), o[1]); }
    { auto rr = __builtin_amdgcn_permlane32_swap(__float_as_uint(l_reg), __float_as_uint(l_reg), false, false); l_reg = __uint_as_float(rr[0]) + __uint_as_float(rr[1]); }
    if (hi == 0) wsf[32 + r32] = l_reg; asm volatile("s_waitcnt lgkmcnt(0)" ::: "memory");
    float rli[16];
#pragma unroll
    for (int r = 0; r < 16; ++r) rli[r] = __builtin_amdgcn_rcpf(wsf[32 + crow(r, hi)]);
    bf16_t* Ow = Oh + (size_t)(rowbase + q0 + wid * QBLK) * OP; bf16_t* stg = (bf16_t*)(lds + LDS_OST) + wid * 2048;
#pragma unroll
    for (int r = 0; r < 16; ++r) { const int orow = crow(r, hi);
#pragma unroll
        for (int d0 = 0; d0 < 2; ++d0) stg[orow * 64 + d0 * 32 + r32] = (bf16_t)f2bf(o[d0][r] * rli[r]); }
    asm volatile("s_waitcnt lgkmcnt(0)" ::: "memory");
#pragma unroll
    for (int i = 0; i < 4; ++i) { const int row = i * 8 + (lane >> 3), ch = lane & 7; *(u32x4*)(Ow + (size_t)row * OP + ch * 8) = *(const u32x4*)(stg + row * 64 + ch * 8); }
    asm volatile("s_waitcnt lgkmcnt(0)\n\ts_barrier" ::: "memory");
#undef DMA_K
#undef DMA_V
#undef ROT
#undef EX0
#undef EX1
#undef BT0
#undef RESC
#undef PKW
#undef PAF
#undef VFR
#undef VRD
#undef KRD
#undef ENDW
#undef GAPA
#undef GAPB0
#undef GAPB1
#undef STEP
}
__device__ __forceinline__ void attn_unit_w(const bf16_t* Qh, const bf16_t* Kh, const bf16_t* Vh, bf16_t* Oh, const int QP, const int KP, const int VP, const int OP,
                                          const int rowbase, const int qb, const float sl2, const unsigned long long* maskp, char* lds, const int tid) {
    constexpr int MODE = 0; constexpr int L_WS = LDS_V + 6 * SLOTB;
    const int lane = tid & 63, r32 = lane & 31, hi = lane >> 5; const int wid = __builtin_amdgcn_readfirstlane(tid >> 6);
    const int q0 = qb * QB, NT = (q0 + QB) / KVBLK;
    const bf16_t* Qw = Qh + (size_t)(rowbase + q0 + wid * QBLK) * QP;
    const unsigned lds0 = (unsigned)(uintptr_t)lds; float* wsf = (float*)(lds + L_WS) + wid * 64;
    const bf16_t* ksrc = Kh + (size_t)rowbase * KP + (size_t)lane * KP + wid * 8;
    const bf16_t* vsrc = Vh + (size_t)rowbase * VP + (size_t)(16 * (wid & 3) + (lane >> 2)) * VP + (wid >> 2) * 32 + (lane & 3) * 8;
    const unsigned kdst = lds0 + LDS_K + wid * 1024, vdst = lds0 + LDS_V + wid * 1024;
#define DMA_K(t, slot) glds16(ksrc + (size_t)(NT - 1 - (t)) * KVBLK * KP, (unsigned)__builtin_amdgcn_readfirstlane(kdst + (slot)))
#define DMA_V(t, slot) do { glds16(vsrc + (size_t)(NT - 1 - (t)) * KVBLK * VP, (unsigned)__builtin_amdgcn_readfirstlane(vdst + 2 * (slot))); \
        glds16(vsrc + 64 + (size_t)(NT - 1 - (t)) * KVBLK * VP, (unsigned)__builtin_amdgcn_readfirstlane(vdst + 2 * (slot) + 8192)); } while (0)
    const lds_cptr vp0 = (lds_cptr)lds + LDS_V + ((lane >> 4) & 1) * 32 + (lane & 3) * 8 + (4 * hi + ((lane & 15) >> 2)) * 64;
    const lds_cptr kp0 = (lds_cptr)lds + LDS_K + hi * 1024 + r32 * 16;
    DMA_K(0, 0); DMA_V(0, 0); DMA_K(1, SLOTB);
    bf16x8 qr[4];
#pragma unroll
    for (int d0 = 0; d0 < 4; ++d0) qr[d0] = *reinterpret_cast<const bf16x8*>(&Qw[(size_t)r32 * QP + d0 * 16 + hi * 8]);
    const int qrel = wid * QBLK + r32;
    const unsigned moff = (unsigned)qrel * 512u;
    unsigned long long mw = 0ull;
    if (MODE == 1) mw = *(const unsigned long long*)((const char*)maskp + (moff + 8u * (unsigned)(NT - 1)));
    float mhat = 0.f, l_reg = 0.f; f32x16 o[4]; o[0] = f32x16{}; o[1] = f32x16{}; o[2] = f32x16{}; o[3] = f32x16{};
    f32x16 bz;
#pragma unroll
    for (int r = 0; r < 16; ++r) bz[r] = sl2 * (float)((r & 3) + 8 * (r >> 2) + 4 * hi - 255) * (1.0f / C2);
    PIN(bz);
    bool resc = false;
    f32x16 pA0, pA1, pB0, pB1; bf16x8 kf[8]; s16x4 vlo[8], vhi[8]; u32x4 pw0, pw1, pw2, pw3;
    int sl_prev = 0, sl_cur = 0, sl_next = SLOTB;
#define ROT() do { sl_prev = sl_cur; sl_cur = sl_next; sl_next = (sl_next == 2 * SLOTB) ? 0 : sl_next + SLOTB; } while (0)
#define EX0(v) __builtin_amdgcn_exp2f(__builtin_fmaf((v), C2, nmh0))
#define EX1(v) __builtin_amdgcn_exp2f(__builtin_fmaf((v), C2, nmh1))
#define BT0(t) (sl2 * (float)(64 * (3 - (t))))
#define RESC() do { if (resc) { _Pragma("unroll") for (int d_ = 0; d_ < 4; ++d_) _Pragma("unroll") for (int r = 0; r < 16; ++r) o[d_][r] *= wsf[crow(r, hi)]; } } while (0)
    DMA_K(2, 2 * SLOTB);
    WAIT_BAR(3);
    _Pragma("unroll") for (int d0 = 0; d0 < 4; ++d0) kload2(kf, kp0, d0);
    pA0 = MFMA(kf[0], qr[0], bz); pA1 = MFMA(kf[1], qr[0], bz); pA0 = MFMA(kf[2], qr[1], pA0); pA1 = MFMA(kf[3], qr[1], pA1);
    pA0 = MFMA(kf[4], qr[2], pA0); pA1 = MFMA(kf[5], qr[2], pA1); pA0 = MFMA(kf[6], qr[3], pA0); pA1 = MFMA(kf[7], qr[3], pA1);
    if (MODE == 0) cmask(pA0, pA1, 3, qrel, hi); else wmask(pA0, pA1, (unsigned)mw, (unsigned)(mw >> 32), hi);
    { const float b0 = BT0(0), b1 = b0 + 32.f * sl2;
      const float rm = halfmax(__builtin_fmaxf(__builtin_fmaf(max16(pA0), C2, b0), __builtin_fmaf(max16(pA1), C2, b1)));
      mhat = __builtin_fmaxf(rm, -1e30f); const float nmh0 = b0 - mhat, nmh1 = b1 - mhat;
#pragma unroll
      for (int r = 0; r < 16; ++r) { pA0[r] = EX0(pA0[r]); pA1[r] = EX1(pA1[r]); } }
    WAIT_BAR(0);
    DMA_K(3, 0); DMA_V(1, SLOTB); ROT();
    _Pragma("unroll") for (int d0 = 0; d0 < 4; ++d0) kload2(kf, kp0 + sl_cur, d0);
    WAIT_BAR(3);
#define PKW(P, i) cvtpk(P[i], P[i + 1])
#define PAF(k) __builtin_bit_cast(bf16x8, pw##k)
#define VFR(i) (bf16x8){vlo[i][0], vlo[i][1], vlo[i][2], vlo[i][3], vhi[i][0], vhi[i][1], vhi[i][2], vhi[i][3]}
#define VRD2(i) do { vlo[i] = vtr(vp_ + (8192 + ((i) >> 2) * 4096 + ((i) & 3) * 1024)); vhi[i] = vtr(vp_ + (8192 + ((i) >> 2) * 4096 + ((i) & 3) * 1024 + 512)); } while (0)
#define VRD(i) do { vlo[i] = vtr(vp_ + (((i) >> 2) * 4096 + ((i) & 3) * 1024)); vhi[i] = vtr(vp_ + (((i) >> 2) * 4096 + ((i) & 3) * 1024 + 512)); } while (0)
#define KRD(G, d0) do { if (G) { kload2(kf, kp0 + sl_next, d0); SBAR(); } } while (0)
#define GAPA(MF, a0, a1, a2, a3, W0, W1, PW) do { MF; sacc += a0; sacc += a1; sacc += a2; sacc += a3; W0; W1; PIN(PW); PIN(sacc); SBAR(); } while (0)
#define GAPH0(MF, X, i) do { MF; X[i] = EX0(X[i]); X[i + 1] = EX0(X[i + 1]); PIN(X); SBAR(); } while (0)
#define GAPH1(MF, X, i) do { MF; X[i] = EX1(X[i]); X[i + 1] = EX1(X[i + 1]); PIN(X); SBAR(); } while (0)
#define GAPB0(MF, X, i) do { MF; X[i] = EX0(X[i]); X[i + 1] = EX0(X[i + 1]); X[i + 2] = EX0(X[i + 2]); X[i + 3] = EX0(X[i + 3]); PIN(X); SBAR(); } while (0)
#define GAPB1(MF, X, i) do { MF; X[i] = EX1(X[i]); X[i + 1] = EX1(X[i + 1]); X[i + 2] = EX1(X[i + 2]); X[i + 3] = EX1(X[i + 3]); PIN(X); SBAR(); } while (0)
#define STEP(C0, C1, P0, P1, t, MASK, GK, GV, GL) do { SBAR(); \
    const lds_cptr vp_ = vp0 + 2 * sl_prev; \
    if (MODE == 1) mw = *(const unsigned long long*)((const char*)maskp + (moff + 8u * (unsigned)(NT - 1 - (t)))); \
    VRD(0); SBAR(); float sacc = P0[0] + P0[1]; \
                    GAPA(C0 = MFMA(kf[0], qr[0], bz), P0[2], P0[3], P0[4], P0[5],     pw0[0] = PKW(P0, 0),  pw0[1] = PKW(P0, 2),  pw0); \
    VRD(4); SBAR(); GAPA(C1 = MFMA(kf[1], qr[0], bz), P0[6], P0[7], P0[8], P0[9],     pw0[2] = PKW(P0, 4),  pw0[3] = PKW(P0, 6),  pw0); \
    VRD(1); SBAR(); GAPA(C0 = MFMA(kf[2], qr[1], C0),    P0[10], P0[11], P0[12], P0[13], pw1[0] = PKW(P0, 8),  pw1[1] = PKW(P0, 10), pw1); \
    VRD(5); SBAR(); GAPA(C1 = MFMA(kf[3], qr[1], C1),    P0[14], P0[15], P1[0], P1[1],   pw1[2] = PKW(P0, 12), pw1[3] = PKW(P0, 14), pw1); \
    VRD(2); SBAR(); GAPA(C0 = MFMA(kf[4], qr[2], C0),    P1[2], P1[3], P1[4], P1[5],     pw2[0] = PKW(P1, 0),  pw2[1] = PKW(P1, 2),  pw2); \
    VRD(6); SBAR(); GAPA(C1 = MFMA(kf[5], qr[2], C1),    P1[6], P1[7], P1[8], P1[9],     pw2[2] = PKW(P1, 4),  pw2[3] = PKW(P1, 6),  pw2); \
    VRD(3); SBAR(); GAPA(C0 = MFMA(kf[6], qr[3], C0),    P1[10], P1[11], P1[12], P1[13], pw3[0] = PKW(P1, 8),  pw3[1] = PKW(P1, 10), pw3); \
    VRD(7); SBAR(); GAPA(C1 = MFMA(kf[7], qr[3], C1),    P1[14], P1[15], 0.f, 0.f,       pw3[2] = PKW(P1, 12), pw3[3] = PKW(P1, 14), pw3); \
    l_reg += sacc; \
    if (MODE == 1) wmask(C0, C1, (unsigned)mw, (unsigned)(mw >> 32), hi); \
    if (GK) DMA_K((t) + 3, sl_cur); if (GV) DMA_V((t) + 1, sl_next); \
    if (MODE == 0) { if (MASK) cmask(C0, C1, 3 - (t), qrel, hi); } \
    const float b0_ = BT0(t), b1_ = b0_ + 32.f * sl2; \
    { const float rma = halfmax(__builtin_fmaxf(__builtin_fmaf(max16(C0), C2, b0_), __builtin_fmaf(max16(C1), C2, b1_))); resc = false;     \
      if (__builtin_expect(__any(rma - mhat > (float)THR), 0)) { const float mn_ = __builtin_fmaxf(mhat, rma); \
          const float f = __builtin_amdgcn_exp2f(mhat - mn_); mhat = mn_; l_reg *= f; if (hi == 0) wsf[r32] = f; resc = true; } } \
    const float nmh0 = b0_ - mhat, nmh1 = b1_ - mhat; SBAR(); \
    GAPH0(o[0] = MFMA(PAF(0), VFR(0), o[0]), C0, 0);  VRD2(0); SBAR(); GAPH0(o[1] = MFMA(PAF(0), VFR(4), o[1]), C0, 2);  VRD2(4); SBAR(); \
    GAPH0(o[0] = MFMA(PAF(1), VFR(1), o[0]), C0, 4);  VRD2(1); SBAR(); GAPH0(o[1] = MFMA(PAF(1), VFR(5), o[1]), C0, 6);  VRD2(5); SBAR(); \
    GAPH0(o[0] = MFMA(PAF(2), VFR(2), o[0]), C0, 8);  VRD2(2); SBAR(); GAPH0(o[1] = MFMA(PAF(2), VFR(6), o[1]), C0, 10); VRD2(6); SBAR(); \
    GAPH0(o[0] = MFMA(PAF(3), VFR(3), o[0]), C0, 12); VRD2(3); SBAR(); GAPH0(o[1] = MFMA(PAF(3), VFR(7), o[1]), C0, 14); VRD2(7); SBAR(); \
    KRD(GL, 0); GAPH1(o[2] = MFMA(PAF(0), VFR(0), o[2]), C1, 0);  KRD(GL, 1); GAPH1(o[3] = MFMA(PAF(0), VFR(4), o[3]), C1, 2); \
    KRD(GL, 2); GAPH1(o[2] = MFMA(PAF(1), VFR(1), o[2]), C1, 4);  KRD(GL, 3); GAPH1(o[3] = MFMA(PAF(1), VFR(5), o[3]), C1, 6); \
    GAPH1(o[2] = MFMA(PAF(2), VFR(2), o[2]), C1, 8);              GAPH1(o[3] = MFMA(PAF(2), VFR(6), o[3]), C1, 10); \
    GAPH1(o[2] = MFMA(PAF(3), VFR(3), o[2]), C1, 12);             GAPH1(o[3] = MFMA(PAF(3), VFR(7), o[3]), C1, 14); \
    } while (0)
#define ENDW(tt) do { if ((tt) + 3 < NT) { WAIT_BAR(3); } else if ((tt) + 2 < NT) { WAIT_BAR(2); } else { WAIT_BAR(0); } } while (0)
    int t = 1;
    for (; t <= 3 && t + 1 < NT; t += 2) {
        STEP(pB0, pB1, pA0, pA1, t, (t <= 3), (t + 3 < NT), (t + 1 < NT), (t + 1 < NT));             ENDW(t);     RESC(); ROT();
        STEP(pA0, pA1, pB0, pB1, t + 1, (t + 1 <= 3), (t + 4 < NT), (t + 2 < NT), (t + 2 < NT));     ENDW(t + 1); RESC(); ROT();
    }
    for (; t + 5 < NT; t += 2) {
        STEP(pB0, pB1, pA0, pA1, t, false, true, true, true);     WAIT_BAR(3); RESC(); ROT();
        STEP(pA0, pA1, pB0, pB1, t + 1, false, true, true, true); WAIT_BAR(3); RESC(); ROT();
    }
    for (; t + 1 < NT; t += 2) {
        STEP(pB0, pB1, pA0, pA1, t, (t <= 3), (t + 3 < NT), (t + 1 < NT), (t + 1 < NT));             ENDW(t);     RESC(); ROT();
        STEP(pA0, pA1, pB0, pB1, t + 1, (t + 1 <= 3), (t + 4 < NT), (t + 2 < NT), (t + 2 < NT));     ENDW(t + 1); RESC(); ROT();
    }
    STEP(pB0, pB1, pA0, pA1, NT - 1, (NT - 1 <= 3), false, false, false); RESC();
    { float sacc = pB0[0] + pB0[1];
#pragma unroll
      for (int r = 2; r < 16; ++r) sacc += pB0[r];
#pragma unroll
      for (int r = 0; r < 16; ++r) sacc += pB1[r];
      l_reg += sacc;
      pw0 = (u32x4){PKW(pB0, 0), PKW(pB0, 2), PKW(pB0, 4), PKW(pB0, 6)}; pw1 = (u32x4){PKW(pB0, 8), PKW(pB0, 10), PKW(pB0, 12), PKW(pB0, 14)};
      pw2 = (u32x4){PKW(pB1, 0), PKW(pB1, 2), PKW(pB1, 4), PKW(pB1, 6)}; pw3 = (u32x4){PKW(pB1, 8), PKW(pB1, 10), PKW(pB1, 12), PKW(pB1, 14)};
      const lds_cptr vp_ = vp0 + 2 * sl_cur; _Pragma("unroll") for (int i = 0; i < 8; ++i) VRD(i);
      o[0] = MFMA(PAF(0), VFR(0), o[0]); o[1] = MFMA(PAF(0), VFR(4), o[1]); o[0] = MFMA(PAF(1), VFR(1), o[0]); o[1] = MFMA(PAF(1), VFR(5), o[1]);
      o[0] = MFMA(PAF(2), VFR(2), o[0]); o[1] = MFMA(PAF(2), VFR(6), o[1]); o[0] = MFMA(PAF(3), VFR(3), o[0]); o[1] = MFMA(PAF(3), VFR(7), o[1]);
      SBAR(); _Pragma("unroll") for (int i = 0; i < 8; ++i) VRD2(i);
      o[2] = MFMA(PAF(0), VFR(0), o[2]); o[3] = MFMA(PAF(0), VFR(4), o[3]); o[2] = MFMA(PAF(1), VFR(1), o[2]); o[3] = MFMA(PAF(1), VFR(5), o[3]);
      o[2] = MFMA(PAF(2), VFR(2), o[2]); o[3] = MFMA(PAF(2), VFR(6), o[3]); o[2] = MFMA(PAF(3), VFR(3), o[2]); o[3] = MFMA(PAF(3), VFR(7), o[3]); }
    { auto rr = __builtin_amdgcn_permlane32_swap(__float_as_uint(l_reg), __float_as_uint(l_reg), false, false); l_reg = __uint_as_float(rr[0]) + __uint_as_float(rr[1]); }
    if (hi == 0) wsf[32 + r32] = l_reg; asm volatile("s_waitcnt lgkmcnt(0)" ::: "memory");
    float rli[16];
#pragma unroll
    for (int r = 0; r < 16; ++r) rli[r] = __builtin_amdgcn_rcpf(wsf[32 + crow(r, hi)]);
    bf16_t* Ow = Oh + (size_t)(rowbase + q0 + wid * QBLK) * OP; bf16_t* stg = (bf16_t*)lds + wid * 4096;
    asm volatile("s_waitcnt lgkmcnt(0)\n\ts_barrier" ::: "memory");
#pragma unroll
    for (int r = 0; r < 16; ++r) { const int orow = crow(r, hi);
#pragma unroll
        for (int d0 = 0; d0 < 4; ++d0) stg[orow * 128 + d0 * 32 + r32] = (bf16_t)f2bf(o[d0][r] * rli[r]); }
    asm volatile("s_waitcnt lgkmcnt(0)" ::: "memory");
#pragma unroll
    for (int i = 0; i < 8; ++i) { const int row = i * 4 + (lane >> 4), ch = lane & 15; *(u32x4*)(Ow + (size_t)row * OP + ch * 8) = *(const u32x4*)(stg + row * 128 + ch * 8); }
    asm volatile("s_waitcnt lgkmcnt(0)\n\ts_barrier" ::: "memory");
#undef DMA_K
#undef DMA_V
#undef ROT
#undef EX0
#undef EX1
#undef BT0
#undef RESC
#undef PKW
#undef PAF
#undef VFR
#undef VRD
#undef VRD2
#undef GAPH0
#undef GAPH1
#undef KRD
#undef ENDW
#undef GAPA
#undef GAPB0
#undef GAPB1
#undef STEP
}
#undef SBAR
#undef PIN
#undef MFMA
#undef WAIT_BAR
#undef MX3
}

__device__ __forceinline__ void diff_attn_phase(const Frame& F, const bf16_t* H, bf16_t* OD) {
    for (int u = F.vcu; u < 512; u += F.G) {
        const int v = u & 255, i = u >> 8, bhc = v >> 3, s = v & 7;
        const int qb = (i == 0) ? 15 - s : s;
        const int b = bhc >> 3, h = (bhc >> 1) & 3, c = bhc & 1;
        const float sl2 = exp2f(-2.0f * (float)(h + 1)) * att::LOG2E;
        const int tidl = F.wave * 64 + fresh_lane();
        att::attn_unit_w(H + O_QC + h * 128 + c * 64, H + O_KC + h * 128 + c * 64, H + O_VC + h * 128, OD + h * 256 + c * 128,
                         ODD_IN, ODD_IN, ODD_IN, D_, b * S_, qb, sl2, nullptr, (char*)F.lds, tidl);
    }
}
__device__ __forceinline__ void dsa_attn_phase(const Frame& F, const bf16_t* H, const unsigned long long* MASK, bf16_t* Y) {
    for (int u = F.vcu; u < 512; u += F.G) {
        const int v = u & 255, i = u >> 8, pair = v >> 3, s = v & 7;
        const int qb = (i == 0) ? s : 15 - s;
        const int b = pair >> 3, h = pair & 7;
        const float sl2 = exp2f(-(float)(h + 1)) * att::LOG2E;
        const int tidl = F.wave * 64 + fresh_lane();
        att::attn_unit<1>(H + E_Q + h * 64, H + E_K + h * 64, H + E_V + h * 64, Y + 512 + h * 64, EVEN_PAD, EVEN_PAD, EVEN_PAD, D_, b * S_, qb, sl2,
                          MASK + ((size_t)b * S_ + qb * 256) * 64, (char*)F.lds, tidl);
    }
}
__device__ __forceinline__ void diff_combine_phase(const Frame& F, const bf16_t* OD, const float* lq1, const float* lk1, const float* lq2, const float* lk2, const float* subg, bf16_t* Y) {
    const int lane = F.lane;
    const float lam_init = 0.8f - 0.6f * expf(-0.3f);
    const float s1 = wave_sum(lq1[lane] * lk1[lane]), s2 = wave_sum(lq2[lane] * lk2[lane]);
    const float lam = expf(s1) - expf(s2) + lam_init;
    const int h = lane >> 4, e0 = (lane & 15) * 8;
    float gsc[8];
#pragma unroll
    for (int j = 0; j < 8; ++j) gsc[j] = subg[e0 + j] * (1.0f - lam_init);
    for (int tok = F.gw; tok < NTOK; tok += F.NGW) {
        const u32x4 a = *(const u32x4*)(OD + (size_t)tok * D_ + h * 256 + e0), bq = *(const u32x4*)(OD + (size_t)tok * D_ + h * 256 + 128 + e0);
        float r[8];
        r[0] = bflo(a.x) - lam * bflo(bq.x); r[1] = bfhi(a.x) - lam * bfhi(bq.x); r[2] = bflo(a.y) - lam * bflo(bq.y); r[3] = bfhi(a.y) - lam * bfhi(bq.y);
        r[4] = bflo(a.z) - lam * bflo(bq.z); r[5] = bfhi(a.z) - lam * bfhi(bq.z); r[6] = bflo(a.w) - lam * bflo(bq.w); r[7] = bfhi(a.w) - lam * bfhi(bq.w);
        float ss = 0.f;
#pragma unroll
        for (int j = 0; j < 8; ++j) ss += r[j] * r[j];
        ss += __shfl_xor(ss, 1); ss += __shfl_xor(ss, 2); ss += __shfl_xor(ss, 4); ss += __shfl_xor(ss, 8);
        const float rs = rsqrtf(ss * (1.0f / 128.0f) + RMS_EPS);
        u32x4 w; w.x = pk2(r[0] * rs * gsc[0], r[1] * rs * gsc[1]); w.y = pk2(r[2] * rs * gsc[2], r[3] * rs * gsc[3]); w.z = pk2(r[4] * rs * gsc[4], r[5] * rs * gsc[5]); w.w = pk2(r[6] * rs * gsc[6], r[7] * rs * gsc[7]);
        *(u32x4*)(Y + (size_t)tok * D_ + h * 128 + e0) = w;
    }
}


namespace dil {
typedef float f32x16 __attribute__((ext_vector_type(16)));
typedef short s16x4 __attribute__((ext_vector_type(4)));
constexpr float C2 = 0.125f * 1.4426950408889634f, LOG2E = 1.4426950408889634f;
#define DMFMA(a, b, c) __builtin_amdgcn_mfma_f32_32x32x16_bf16(a, b, c, 0, 0, 0)
template <int PH> __device__ __forceinline__ void tile_desc(int j, int& g, int& tile) {
    if (PH == 0) { g = 0; tile = 4 - j; } else { g = j < 8 ? 1 : 2; tile = j < 8 ? 7 - j : 12 - j; } }
__device__ __forceinline__ int clamp_s(int sk) { return sk < 0 ? 0 : (sk > S_ - 1 ? S_ - 1 : sk); }
template <int PH> __device__ __forceinline__ void dil_task(const Frame& F, const bf16_t* H, bf16_t* Y, float* PB, float2* PM, int b, int h, int blk, int sub) {
        constexpr int NT = PH == 0 ? 5 : 13, QS = PH == 0 ? 1 : 16;
        const int lane = fresh_lane();
        const int r32 = lane & 31, hi = lane >> 5;
        char* ldsw = (char*)F.lds + F.wave * 16384;
        const unsigned ldsv = (unsigned)(uintptr_t)ldsw;
        const att::lds_cptr vp0 = (att::lds_cptr)ldsw + 8192 + ((lane >> 4) & 1) * 32 + (lane & 3) * 8 + (4 * hi + ((lane & 15) >> 2)) * 64;
        const att::lds_cptr kp0 = (att::lds_cptr)ldsw + r32 * 128;
        const int u0 = blk * 512 + (PH == 0 ? 32 * sub : sub); const size_t rb = (size_t)b * S_;
        const float sl2 = exp2f(-(float)(h + 1)) * LOG2E;
        const bf16_t* Qp = H + (rb + u0 + QS * r32) * ODD_IN + O_QD + h * 64 + 8 * hi;
        const bf16_t* Kb = H + rb * ODD_IN + O_KD + h * 64 + ((lane & 7) ^ (lane >> 3)) * 8;
        const bf16_t* Vb = H + rb * ODD_IN + O_VD + h * 64 + (lane & 3) * 8;
        asm volatile("s_waitcnt vmcnt(0)" ::: "memory");
#define DIL_ISSUE(j_) do { int g_, tl_; tile_desc<PH>((j_), g_, tl_); const int st_ = 1 << (2 * g_), s0_ = u0 - (128 << (2 * g_)) + (st_ << 5) * tl_; \
            const unsigned kdst_ = (unsigned)__builtin_amdgcn_readfirstlane(ldsv + ((j_) & 1) * 4096), vdst_ = kdst_ + 8192u; \
            if (s0_ >= 0 && s0_ + 31 * st_ < S_) {              \
                const bf16_t* kp_ = Kb + (size_t)(s0_ + st_ * (lane >> 3)) * ODD_IN; const bf16_t* vp_ = Vb + (size_t)(s0_ + st_ * (lane >> 2)) * ODD_IN; const size_t ks_ = (size_t)(8 * st_) * ODD_IN; \
                _Pragma("unroll") for (int c = 0; c < 4; ++c) att::glds16(kp_ + c * ks_, kdst_ + c * 1024); \
                _Pragma("unroll") for (int c = 0; c < 4; ++c) att::glds16(vp_ + (c & 1) * 2 * ks_ + (c >> 1) * 32, vdst_ + c * 1024); \
            } else { \
                _Pragma("unroll") for (int c = 0; c < 4; ++c) { const int sk = clamp_s(s0_ + st_ * (8 * c + (lane >> 3))); att::glds16(Kb + (size_t)sk * ODD_IN, kdst_ + c * 1024); } \
                _Pragma("unroll") for (int c = 0; c < 4; ++c) { const int sk = clamp_s(s0_ + st_ * (16 * (c & 1) + (lane >> 2))); att::glds16(Vb + (size_t)sk * ODD_IN + (c >> 1) * 32, vdst_ + c * 1024); } } } while (0)
        DIL_ISSUE(0);
        bf16x8 qr[4];
#pragma unroll
        for (int d0 = 0; d0 < 4; ++d0) qr[d0] = *(const bf16x8*)(Qp + 16 * d0);
        float mhat = -1e30f, l_reg = 0.f; f32x16 o[2]; o[0] = f32x16{}; o[1] = f32x16{};
        if (PH == 1) {
            const float2 ml = PM[sub + 16 * r32]; mhat = ml.x; l_reg = hi ? 0.f : ml.y;
            const float* PBp = PB + (size_t)sub * 64 + r32;
#pragma unroll
            for (int r = 0; r < 16; ++r) { const int row = att::crow(r, hi); o[0][r] = PBp[(size_t)(16 * row) * 64]; o[1][r] = PBp[(size_t)(16 * row) * 64 + 32]; }
        }
        asm volatile("" : "+v"(o[0]), "+v"(o[1]), "+v"(mhat), "+v"(l_reg), "+v"(qr[0]), "+v"(qr[1]), "+v"(qr[2]), "+v"(qr[3]));
        int gprev = -1; f32x16 bz = f32x16{};
#pragma unroll 1
        for (int j = 0; j < NT; ++j) {
            int g, tile; tile_desc<PH>(j, g, tile);
            const int ST = 1 << (2 * g), W = 128 << (2 * g);
            if (g != gprev) { gprev = g;
#pragma unroll
                for (int r = 0; r < 16; ++r) bz[r] = sl2 * (float)(ST * ((r & 3) + 8 * (r >> 2) + 4 * hi)) * (1.0f / C2); }
            const int s0t = u0 - W + ST * 32 * tile;
            if (j + 1 < NT) { DIL_ISSUE(j + 1); asm volatile("s_waitcnt vmcnt(8)" ::: "memory"); } else asm volatile("s_waitcnt vmcnt(0)" ::: "memory");
            bf16x8 kf[4];
            { const att::lds_cptr kpj = kp0 + (j & 1) * 4096;
#pragma unroll
              for (int d0 = 0; d0 < 4; ++d0) kf[d0] = *(const __attribute__((address_space(3))) bf16x8*)(kpj + (((2 * d0 + hi) ^ (r32 & 7)) * 16)); }
            f32x16 C0 = DMFMA(kf[0], qr[0], bz);
            C0 = DMFMA(kf[1], qr[1], C0); C0 = DMFMA(kf[2], qr[2], C0); C0 = DMFMA(kf[3], qr[3], C0);
            __builtin_amdgcn_sched_barrier(0);
            const int dq = QS * r32 + W - ST * 32 * tile - ST * 4 * hi;
            int kmin = 0; if (s0t < 0) kmin = (-s0t + ST - 1) >> (2 * g);
            const int km0 = kmin - 4 * hi;
            unsigned vmask;
            { const int hx = dq >> (2 * g); int lx = (dq - W + ST - 1) >> (2 * g); lx = lx > km0 ? lx : km0; lx = lx > 0 ? lx : 0;
              const unsigned up = hx >= 31 ? 0xFFFFFFFFu : ((2u << (hx & 31)) - 1u), dn = lx > 31 ? 0xFFFFFFFFu : ((1u << (lx & 31)) - 1u);
              vmask = (hx < 0 || lx > hx) ? 0u : (up & ~dn); }
#pragma unroll
            for (int r = 0; r < 16; ++r) { const int cr = (r & 3) + 8 * (r >> 2); const unsigned t_ = (unsigned)((int)(vmask << (31 - cr)) >> 31);
                C0[r] = __uint_as_float((__float_as_uint(C0[r]) & t_) | (0xff800000u & ~t_)); }
            const float nb0 = -sl2 * (float)(QS * r32 + W - ST * 32 * tile);
            const float rma = att::halfmax(__builtin_fmaf(att::max16(C0), C2, nb0));
            if (__any(rma - mhat > 6.0f)) {
                const float mn_ = __builtin_fmaxf(mhat, rma); const float f = __builtin_amdgcn_exp2f(mhat - mn_); mhat = mn_; l_reg *= f;
#pragma unroll
                for (int r = 0; r < 16; ++r) {
                    const float f0 = __builtin_bit_cast(float, __builtin_amdgcn_readlane(__builtin_bit_cast(int, f), (r & 3) + 8 * (r >> 2)));
                    const float f1 = __builtin_bit_cast(float, __builtin_amdgcn_readlane(__builtin_bit_cast(int, f), (r & 3) + 8 * (r >> 2) + 4));
                    const float fr = hi ? f1 : f0; o[0][r] *= fr; o[1][r] *= fr; }
            }
            const float nmh0 = nb0 - mhat;
            float sacc = 0.f;
#pragma unroll
            for (int r = 0; r < 16; ++r) { C0[r] = __builtin_amdgcn_exp2f(__builtin_fmaf(C0[r], C2, nmh0)); sacc += C0[r]; }
            l_reg += sacc;
            u32x4 pw0, pw1;
            pw0 = (u32x4){att::cvtpk(C0[0], C0[1]), att::cvtpk(C0[2], C0[3]), att::cvtpk(C0[4], C0[5]), att::cvtpk(C0[6], C0[7])};
            pw1 = (u32x4){att::cvtpk(C0[8], C0[9]), att::cvtpk(C0[10], C0[11]), att::cvtpk(C0[12], C0[13]), att::cvtpk(C0[14], C0[15])};
            asm volatile("s_nop 1" : "+v"(pw0), "+v"(pw1));
            {
                const att::lds_cptr vpj = vp0 + (j & 1) * 4096;
                s16x4 vlo[4], vhi[4];
#define DVFR(i) (bf16x8){vlo[i][0], vlo[i][1], vlo[i][2], vlo[i][3], vhi[i][0], vhi[i][1], vhi[i][2], vhi[i][3]}
#pragma unroll
                for (int i = 0; i < 4; ++i) { vlo[i] = att::vtr(vpj + ((i >> 1) * 2048 + (i & 1) * 1024)); vhi[i] = att::vtr(vpj + ((i >> 1) * 2048 + (i & 1) * 1024 + 512)); }
                o[0] = DMFMA(__builtin_bit_cast(bf16x8, pw0), DVFR(0), o[0]); o[1] = DMFMA(__builtin_bit_cast(bf16x8, pw0), DVFR(2), o[1]);
                o[0] = DMFMA(__builtin_bit_cast(bf16x8, pw1), DVFR(1), o[0]); o[1] = DMFMA(__builtin_bit_cast(bf16x8, pw1), DVFR(3), o[1]);
                __builtin_amdgcn_sched_barrier(0);
#undef DVFR
            }
            asm volatile("s_waitcnt lgkmcnt(0)" ::: "memory");
        }
#undef DIL_ISSUE
        { auto rr = __builtin_amdgcn_permlane32_swap(__float_as_uint(l_reg), __float_as_uint(l_reg), false, false); l_reg = __uint_as_float(rr[0]) + __uint_as_float(rr[1]); }
        const int lane3 = fresh_lane();
        const int hi3 = lane3 >> 5;
        if (PH == 0) {
            float* PBp = PB + (size_t)(32 * sub) * 64 + (lane3 & 31);
#pragma unroll
            for (int r = 0; r < 16; ++r) { const int row = att::crow(r, hi3); PBp[row * 64] = o[0][r]; PBp[row * 64 + 32] = o[1][r]; }
            if (hi3 == 0) PM[32 * sub + lane3] = make_float2(mhat, l_reg);
        } else {
            const float rl = __builtin_amdgcn_rcpf(l_reg);
            bf16_t* Yp = Y + (rb + u0) * D_ + 512 + h * 64 + (lane3 & 31);
#pragma unroll
            for (int r = 0; r < 16; ++r) { const int row = att::crow(r, hi3); const float rli = __shfl(rl, row);
                Yp[(size_t)(16 * row) * D_] = (bf16_t)f2bf(o[0][r] * rli); Yp[(size_t)(16 * row) * D_ + 32] = (bf16_t)f2bf(o[1][r] * rli); }
        }
}
__device__ __forceinline__ void dil_phase(const Frame& F, const bf16_t* H, bf16_t* Y, float* PBALL) {
    for (int unit = F.vcu; unit < 256; unit += F.G) {
        const int h = unit & 7, blk = (unit >> 3) & 7, b = unit >> 6;
        float* PB = PBALL + (size_t)unit * (512 * 64 + 1024); float2* PM = (float2*)(PB + 512 * 64);
        dil_task<0>(F, H, Y, PB, PM, b, h, blk, F.wave); dil_task<0>(F, H, Y, PB, PM, b, h, blk, F.wave + 8);
        __syncthreads();
        dil_task<1>(F, H, Y, PB, PM, b, h, blk, F.wave); dil_task<1>(F, H, Y, PB, PM, b, h, blk, F.wave + 8);
        __syncthreads();
    }
}
#undef DMFMA
}

template <bool XBF>
__device__ __forceinline__ void ln_router_phase(const Frame& F, const void* xin_, const bf16_t* Mb, const float* g, const float* bta, const float* rw, const float* rb,
                                                bf16_t* X1B, int* bcnt, const bool dry = false) {
    typedef float f32x16 __attribute__((ext_vector_type(16)));
    LAS int* lcnt = (LAS int*)(F.lds + ROUTE_OFF);
    LAS int* recs = (LAS int*)(F.lds + ROUTE_OFF + 256);
    if (F.tid < NE) lcnt[F.tid] = 0;
    LAS float* pl = (LAS float*)F.lds;
    LAS float* ps = (LAS float*)(F.lds + 32768);
    const int lane = F.lane, r = lane & 31, kh = lane >> 5, tile = F.wave >> 2, kq = F.wave & 3;
    {
        const int row = F.vcu * NWAVES + (r & 7) + F.NGW * (4 * tile + (r >> 3));
        const int k0 = kq * 256 + kh * 128;
        float v[128];
        { const u32x4* mp = (const u32x4*)(Mb + (size_t)row * D_ + k0);
          if (XBF) { const u32x4* xp = (const u32x4*)((const bf16_t*)xin_ + (size_t)row * D_ + k0);
#pragma unroll
              for (int j = 0; j < 16; ++j) { const u32x4 xw = xp[j], mw = mp[j];
                  v[8 * j + 0] = ALPHA * bflo(xw.x) + bflo(mw.x); v[8 * j + 1] = ALPHA * bfhi(xw.x) + bfhi(mw.x); v[8 * j + 2] = ALPHA * bflo(xw.y) + bflo(mw.y); v[8 * j + 3] = ALPHA * bfhi(xw.y) + bfhi(mw.y);
                  v[8 * j + 4] = ALPHA * bflo(xw.z) + bflo(mw.z); v[8 * j + 5] = ALPHA * bfhi(xw.z) + bfhi(mw.z); v[8 * j + 6] = ALPHA * bflo(xw.w) + bflo(mw.w); v[8 * j + 7] = ALPHA * bfhi(xw.w) + bfhi(mw.w); }
          } else { const f32x4* xp = (const f32x4*)((const float*)xin_ + (size_t)row * D_ + k0);
#pragma unroll
              for (int j = 0; j < 16; ++j) { const f32x4 xa = xp[2 * j], xb = xp[2 * j + 1]; const u32x4 mw = mp[j];
                  v[8 * j + 0] = ALPHA * xa[0] + bflo(mw.x); v[8 * j + 1] = ALPHA * xa[1] + bfhi(mw.x); v[8 * j + 2] = ALPHA * xa[2] + bflo(mw.y); v[8 * j + 3] = ALPHA * xa[3] + bfhi(mw.y);
                  v[8 * j + 4] = ALPHA * xb[0] + bflo(mw.z); v[8 * j + 5] = ALPHA * xb[1] + bfhi(mw.z); v[8 * j + 6] = ALPHA * xb[2] + bflo(mw.w); v[8 * j + 7] = ALPHA * xb[3] + bfhi(mw.w); } } }
        float s0 = 0.f, s1 = 0.f, s2 = 0.f, s3 = 0.f;
#pragma unroll
        for (int i = 0; i < 128; i += 4) { s0 += v[i]; s1 += v[i + 1]; s2 += v[i + 2]; s3 += v[i + 3]; }
        float s = (s0 + s1) + (s2 + s3);
        { auto rr = __builtin_amdgcn_permlane32_swap(__float_as_uint(s), __float_as_uint(s), false, false); s = __uint_as_float(rr[0]) + __uint_as_float(rr[1]); }
        if (kh == 0) ps[F.wave * 32 + r] = s;
        __syncthreads();
        const float mean = ((ps[(tile * 4 + 0) * 32 + r] + ps[(tile * 4 + 1) * 32 + r]) + (ps[(tile * 4 + 2) * 32 + r] + ps[(tile * 4 + 3) * 32 + r])) * (1.0f / D_);
        float q0 = 0.f, q1 = 0.f, q2 = 0.f, q3 = 0.f;
#pragma unroll
        for (int i = 0; i < 128; i += 4) { v[i] -= mean; v[i + 1] -= mean; v[i + 2] -= mean; v[i + 3] -= mean; q0 += v[i] * v[i]; q1 += v[i + 1] * v[i + 1]; q2 += v[i + 2] * v[i + 2]; q3 += v[i + 3] * v[i + 3]; }
        float q = (q0 + q1) + (q2 + q3);
        { auto rr = __builtin_amdgcn_permlane32_swap(__float_as_uint(q), __float_as_uint(q), false, false); q = __uint_as_float(rr[0]) + __uint_as_float(rr[1]); }
        if (kh == 0) ps[256 + F.wave * 32 + r] = q;
        __syncthreads();
        const float rstd = rsqrtf(((ps[256 + (tile * 4 + 0) * 32 + r] + ps[256 + (tile * 4 + 1) * 32 + r]) + (ps[256 + (tile * 4 + 2) * 32 + r] + ps[256 + (tile * 4 + 3) * 32 + r])) * (1.0f / D_) + LN_EPS);
        const f32x4* gp = (const f32x4*)(g + k0); const f32x4* bp = (const f32x4*)(bta + k0);
        u32x4* op = (u32x4*)(X1B + (size_t)row * D_ + k0);
#pragma unroll
        for (int c = 0; c < 8; ++c) {
#pragma unroll
            for (int j = 0; j < 4; ++j) { const f32x4 gg = gp[4 * c + j], bb = bp[4 * c + j];
#pragma unroll
                for (int e = 0; e < 4; ++e) v[16 * c + 4 * j + e] = v[16 * c + 4 * j + e] * rstd * gg[e] + bb[e]; }
            u32x4 w0, w1;
            w0.x = pk2(v[16 * c + 0], v[16 * c + 1]); w0.y = pk2(v[16 * c + 2], v[16 * c + 3]); w0.z = pk2(v[16 * c + 4], v[16 * c + 5]); w0.w = pk2(v[16 * c + 6], v[16 * c + 7]);
            w1.x = pk2(v[16 * c + 8], v[16 * c + 9]); w1.y = pk2(v[16 * c + 10], v[16 * c + 11]); w1.z = pk2(v[16 * c + 12], v[16 * c + 13]); w1.w = pk2(v[16 * c + 14], v[16 * c + 15]);
            op[2 * c] = w0; op[2 * c + 1] = w1;
        }
        f32x16 acc = {0.f, 0.f, 0.f, 0.f, 0.f, 0.f, 0.f, 0.f, 0.f, 0.f, 0.f, 0.f, 0.f, 0.f, 0.f, 0.f};
        const float* bptr = rw + (size_t)k0 * NE + r;
        float bq[2][16];
#pragma unroll
        for (int i = 0; i < 16; ++i) bq[0][i] = bptr[i * NE];
#pragma unroll
        for (int c = 0; c < 8; ++c) {
            if (c + 1 < 8) {
#pragma unroll
                for (int i = 0; i < 16; ++i) bq[(c + 1) & 1][i] = bptr[(16 * (c + 1) + i) * NE]; }
#pragma unroll
            for (int i = 0; i < 16; ++i) acc = __builtin_amdgcn_mfma_f32_32x32x2f32(v[16 * c + i], bq[c & 1][i], acc, 0, 0, 0);
            __builtin_amdgcn_sched_barrier(0);
        }
#pragma unroll
        for (int rr = 0; rr < 16; ++rr) pl[(F.wave * 32 + (rr & 3) + 8 * (rr >> 2) + 4 * kh) * 32 + r] = acc[rr];
    }
    __syncthreads();
    for (int it_ = 0; it_ < 8; ++it_) {
        float logit = -INFINITY;
        if (lane < NE) { const LAS float* pp = pl + (((it_ >> 2) * 4) * 32 + (it_ & 3) * 8 + F.wave) * 32 + lane; logit = ((pp[0] + pp[1024]) + (pp[2048] + pp[3072])) + rb[lane]; }
        float tv[TOPK]; int ti[TOPK];
#pragma unroll
        for (int k = 0; k < TOPK; ++k) {
            const float mx = wave_max_u(logit);
            const int bi = (int)__builtin_ctzll(__ballot(logit == mx));
            tv[k] = mx; ti[k] = bi; if (lane == bi) logit = -INFINITY;
        }
        float ex[TOPK], den = 0.f;
#pragma unroll
        for (int k = 0; k < TOPK; ++k) { ex[k] = __expf(tv[k] - tv[0]); den += ex[k]; }
        if (lane < TOPK) {
            int e = ti[0]; float gt = ex[0];
#pragma unroll
            for (int k = 1; k < TOPK; ++k) if (lane == k) { e = ti[k]; gt = ex[k]; }
            const int lr = __hip_atomic_fetch_add((LAS int*)&lcnt[e], 1, __ATOMIC_RELAXED, __HIP_MEMORY_SCOPE_WORKGROUP);
            LAS int* rc = recs + ((F.wave * 8 + it_) * 4 + lane) * 3; rc[0] = e; rc[1] = lr; rc[2] = (int)__float_as_uint(gt / den);
        }
    }
    __syncthreads();
    if (F.tid < NE && !dry) bcnt[F.vcu * NE + F.tid] = lcnt[F.tid];
}

__device__ __forceinline__ int route_fill(const Frame& F, const int* bcnt, int* tk_e, int* tk_rank, float* tk_gate, int* slot_tok) {
    LAS int* tile_e = (LAS int*)(F.lds + TILE_E_OFF); LAS int* tile_f = (LAS int*)(F.lds + TILE_F_OFF); LAS int* ebase = (LAS int*)(F.lds + EBASE_OFF); LAS int* ecnt = (LAS int*)(F.lds + ECNT_OFF);
    LAS int* lbase = (LAS int*)(F.lds + ROUTE_OFF); const LAS int* recs = (const LAS int*)(F.lds + ROUTE_OFF + 256); LAS int* part = (LAS int*)(F.lds + ROUTE_OFF + 3328);
    { const int e = F.tid & 31, p = F.tid >> 5; int sa = 0, sb = 0;
      for (int v = p * 16; v < p * 16 + 16; ++v) if (v < F.G) { const int c = bcnt[v * NE + e]; sa += c; sb += (v < F.vcu) ? c : 0; }
      part[(p * 32 + e) * 2] = sa; part[(p * 32 + e) * 2 + 1] = sb; }
    __syncthreads();
    if (F.tid < NE) { int sa = 0, sb = 0; for (int p = 0; p < 16; ++p) { sa += part[(p * 32 + F.tid) * 2]; sb += part[(p * 32 + F.tid) * 2 + 1]; } ecnt[F.tid] = sa; lbase[F.tid] = sb; }
    __syncthreads();
    if (F.tid == 0) { int run = 0; for (int e = 0; e < NE; ++e) { ebase[e] = run; run += (ecnt[e] + 255) / 256; } ebase[NE] = run; }
    { int it2 = 0; const int lane = F.lane;
      for (int row = F.gw; row < NTOK; row += F.NGW, ++it2) if (lane < TOPK) {
          const LAS int* rc = recs + ((F.wave * 8 + it2) * 4 + lane) * 3; const int e = rc[0], rank = lbase[e] + rc[1];
          tk_e[row * TOPK + lane] = e; tk_rank[row * TOPK + lane] = rank; tk_gate[row * TOPK + lane] = __uint_as_float((unsigned)rc[2]);
          slot_tok[e * NTOK + rank] = row; } }
    __syncthreads();
    const int ntile = ebase[NE];
    for (int tl = F.tid; tl < ntile; tl += NTHR) { int e = 0; while (e + 1 < NE && ebase[e + 1] <= tl) ++e; tile_e[tl] = e; tile_f[tl] = tl - ebase[e]; }
    __syncthreads();
    return ntile;
}

__device__ __forceinline__ void combine_ln_phase(const Frame& F, const bf16_t* X1B, const bf16_t* YA, const int* tk_e, const int* tk_rank, const float* tk_gate,
                                                 const float* g, const float* bta, float* out, bf16_t* XB) {
    const LAS int* ebase = (const LAS int*)(F.lds + EBASE_OFF);
    const int lane = F.lane;
    f32x4 gv[4], bv[4];
#pragma unroll
    for (int j = 0; j < 4; ++j) { gv[j] = *((const f32x4*)g + lane + 64 * j); bv[j] = *((const f32x4*)bta + lane + 64 * j); }
    for (int row0 = F.gw; row0 < NTOK; row0 += 2 * F.NGW) {
        int rows[2]; rows[0] = row0; rows[1] = row0 + F.NGW < NTOK ? row0 + F.NGW : row0;
        const u32x2* yr[2][TOPK]; float gt[2][TOPK];
#pragma unroll
        for (int r = 0; r < 2; ++r)
#pragma unroll
            for (int k = 0; k < TOPK; ++k) { const int e = tk_e[rows[r] * TOPK + k], rk = tk_rank[rows[r] * TOPK + k]; gt[r][k] = tk_gate[rows[r] * TOPK + k];
                yr[r][k] = (const u32x2*)(YA + ((size_t)ebase[e] * 256 + rk) * D_) + lane; }
        u32x2 xw[2][4], yw[2][TOPK][4];
#pragma unroll
        for (int r = 0; r < 2; ++r) { const u32x2* xr = (const u32x2*)(X1B + (size_t)rows[r] * D_) + lane;
#pragma unroll
            for (int j = 0; j < 4; ++j) { xw[r][j] = xr[64 * j];
#pragma unroll
                for (int k = 0; k < TOPK; ++k) yw[r][k][j] = yr[r][k][64 * j]; } }
#pragma unroll
        for (int r = 0; r < 2; ++r) {
            if (r == 1 && rows[1] == rows[0]) break;
            const int row = rows[r];
            f32x4 v[4]; float s = 0.f;
#pragma unroll
            for (int j = 0; j < 4; ++j) { const f32x4 x = {bflo(xw[r][j].x), bfhi(xw[r][j].x), bflo(xw[r][j].y), bfhi(xw[r][j].y)}; f32x4 f = {0.f, 0.f, 0.f, 0.f};
#pragma unroll
                for (int k = 0; k < TOPK; ++k) { const u32x2 w = yw[r][k][j]; f[0] += gt[r][k] * bflo(w.x); f[1] += gt[r][k] * bfhi(w.x); f[2] += gt[r][k] * bflo(w.y); f[3] += gt[r][k] * bfhi(w.y); }
                v[j] = ALPHA * x + f; s += (v[j][0] + v[j][1]) + (v[j][2] + v[j][3]); }
            const float mean = wave_sum_u(s) * (1.0f / D_); float q = 0.f;
#pragma unroll
            for (int j = 0; j < 4; ++j) { v[j] = v[j] - mean; q += (v[j][0] * v[j][0] + v[j][1] * v[j][1]) + (v[j][2] * v[j][2] + v[j][3] * v[j][3]); }
            const float rstd = rsqrtf(wave_sum_u(q) * (1.0f / D_) + LN_EPS);
#pragma unroll
            for (int j = 0; j < 4; ++j) v[j] = v[j] * rstd * gv[j] + bv[j];
            if (out) { f32x4* orow = (f32x4*)(out + (size_t)row * D_) + lane;
#pragma unroll
                for (int j = 0; j < 4; ++j) orow[64 * j] = v[j]; }
            if (XB) { u32x2* xb = (u32x2*)(XB + (size_t)row * D_) + lane;
#pragma unroll
                for (int j = 0; j < 4; ++j) { u32x2 w; w.x = pk2(v[j][0], v[j][1]); w.y = pk2(v[j][2], v[j][3]); xb[64 * j] = w; } }
        }
    }
}

constexpr int PTAB_OFF = CTL_OFF + 4096;
__device__ __forceinline__ const float* ptab_ld(LAS unsigned char* lds, int i) {
    const LAS unsigned* p = (const LAS unsigned*)(lds + PTAB_OFF) + 2 * i;
    const unsigned lo = __builtin_amdgcn_readfirstlane(p[0]), hi = __builtin_amdgcn_readfirstlane(p[1]);
    return (const float*)(((unsigned long long)hi << 32) | lo);
}
#define INP(i) ptab_ld(F.lds, (i))
#define OUTP() ((float*)ptab_ld(F.lds, 31))
#define WSP() ((unsigned char*)ptab_ld(F.lds, 32))
#define LAUNDER_S(x) do { int _v = (x); asm volatile("" : "+v"(_v)); (x) = __builtin_amdgcn_readfirstlane(_v); } while (0)
#define PHASE_BEGIN() do { LAUNDER_S(F.G); LAUNDER_S(F.vcu); LAUNDER_S(F.gw); LAUNDER_S(F.NGW); LAUNDER_S(F.wave); LAUNDER_S(F.bx); \
        { int _o = -1; asm volatile("" : "+v"(_o)); const unsigned _m = (unsigned)__builtin_amdgcn_readfirstlane(_o); F.lane = (int)__builtin_amdgcn_mbcnt_hi(_m, __builtin_amdgcn_mbcnt_lo(_m, 0u)); F.tid = F.wave * 64 + F.lane; } \
        { unsigned _l = (unsigned)(uintptr_t)F.lds; asm volatile("" : "+v"(_l)); F.lds = (LAS unsigned char*)(uintptr_t)(unsigned)__builtin_amdgcn_readfirstlane((int)_l); } } while (0)
#define GRID_BAR() xcd_barrier(bar, F.wave == 0 && fresh_lane() == 0)
#define TILE_E ((const LAS int*)(F.lds + TILE_E_OFF))
#define TILE_F ((const LAS int*)(F.lds + TILE_F_OFF))
#define ECNT ((const LAS int*)(F.lds + ECNT_OFF))
template <int layer>
__device__ __forceinline__ void run_layer(Frame& F, const XcdBarrier& bar) {
        const int lb = layer == 0 ? 0 : 17;
        const int NP = layer == 0 ? EVEN_PAD : ODD_IN;
        constexpr size_t WOFF = layer == 0 ? 0 : WS_W1OFF;
        constexpr int TAIL_BATCHES = 3;
        PHASE_BEGIN();
        { unsigned char* ws = WSP(); pg8::DenseSched S; S.init(ws + WS_XB, ws + WOFF + WS_WIN, NTOK, NP, D_, F.G, F.bx); pg8::EpiBf16 E{(bf16_t*)(ws + WS_H), NP};
          pg8::gemm_phase<pg8::EpiBf16, pg8::DenseSched, false>(F.lds, D_, S, E, F.tid); }
        if (layer == 0) { const int nu_ = (NTOK / 256) * (NP / 256), my_ = (nu_ - F.bx + F.G - 1) / F.G, mx_ = (nu_ + F.G - 1) / F.G;
          if (my_ < mx_) { ConvJob J{INP(14), ODD_IN, ODD_IN, INP(20), INP(25), INP(27), WS_W1OFF}; convert_queue(F, J, (int*)(WSP() + WS_CTL) + CW_CONV, (mx_ - my_) * TAIL_BATCHES); } }
        GRID_BAR();
        PHASE_BEGIN();
        { unsigned char* ws = WSP();
          if (layer == 0) { conv_phase(F, (const bf16_t*)(ws + WS_H), INP(2), (bf16_t*)(ws + WS_Y));
                            { ConvJob J0{INP(1), EVEN_IN, EVEN_PAD, INP(3), INP(8), INP(10), 0};
                              dsa_select_phase(F, (const bf16_t*)(ws + WS_H), (unsigned long long*)(ws + WS_X1), J0, (int*)(ws + WS_CTL) + CW_CONV + 64, 16 * (EVEN_PAD / 64) + 256); } }
          else { diff_attn_phase(F, (const bf16_t*)(ws + WS_H), (bf16_t*)(ws + WS_MB));
                 dil::dil_phase(F, (const bf16_t*)(ws + WS_H), (bf16_t*)(ws + WS_Y), (float*)(ws + WS_YA)); } }
        GRID_BAR();
        if (layer == 0) { PHASE_BEGIN(); unsigned char* ws = WSP();
          dsa_attn_phase(F, (const bf16_t*)(ws + WS_H), (const unsigned long long*)(ws + WS_X1), (bf16_t*)(ws + WS_Y));
          GRID_BAR(); }
        if (layer == 1) { PHASE_BEGIN(); unsigned char* ws = WSP();
          diff_combine_phase(F, (const bf16_t*)(ws + WS_MB), INP(15), INP(16), INP(17), INP(18), INP(19), (bf16_t*)(ws + WS_Y));
          GRID_BAR(); }
        PHASE_BEGIN();
        { unsigned char* ws = WSP(); pg8::DenseSched S; S.init(ws + WS_Y, ws + WOFF + WS_WOUT, NTOK, D_, D_, F.G, F.bx); pg8::EpiBf16 E{(bf16_t*)(ws + WS_MB), D_};
          pg8::gemm_phase<pg8::EpiBf16, pg8::DenseSched, false>(F.lds, D_, S, E, F.tid); }
        GRID_BAR();
        PHASE_BEGIN();
        { unsigned char* ws = WSP();
          ln_router_phase<layer == 1>(F, layer == 0 ? (const void*)INP(0) : (const void*)(ws + WS_XB), (const bf16_t*)(ws + WS_MB), INP(4 + lb), INP(5 + lb), INP(6 + lb), INP(7 + lb),
                          (bf16_t*)(ws + WS_X1B), (int*)(ws + WS_CTL) + CW_BCNT); }
        GRID_BAR();
        PHASE_BEGIN();
        int ntile;
        { unsigned char* ws = WSP();
          ntile = route_fill(F, (const int*)(ws + WS_CTL) + CW_BCNT, (int*)(ws + WS_TKE), (int*)(ws + WS_TKR), (float*)(ws + WS_TKG), (int*)(ws + WS_SLOT)); }
        if (layer == 0) { ConvJob J0{INP(1), EVEN_IN, EVEN_PAD, INP(3), INP(8), INP(10), 0};
          convert_queue(F, J0, (int*)(WSP() + WS_CTL) + CW_CONV + 64, 1 << 30, 1, 16 * (EVEN_PAD / 64) + 256); }
        GRID_BAR();
        PHASE_BEGIN();
        { unsigned char* ws = WSP(); pg8::MoeSched S; S.A = (const char*)(ws + WS_X1B); S.Bt = (const char*)(ws + WOFF + WS_WGU); S.slot_tok = (const int*)(ws + WS_SLOT); S.tile_e = TILE_E; S.tile_f = TILE_F; S.ecnt = ECNT;
          S.NPN = 8; S.n_units = ntile * 8; S.G = F.G; S.c = F.bx; S.bexp = (size_t)2 * DFF * D_ * 2; S.gather = true;
          pg8::EpiAct E{(bf16_t*)(ws + WS_ACT), INP(9 + lb), TILE_E};
          pg8::gemm_phase<pg8::EpiAct, pg8::MoeSched, true>(F.lds, D_, S, E, F.tid); }
        if (layer == 0) { pg8::MoeSched S_; S_.NPN = 8; S_.n_units = ntile * 8; S_.G = F.G; S_.c = F.bx; const int nu_ = ntile * 8, my_ = S_.my_units(), mx_ = (nu_ + F.G - 1) / F.G;
          if (my_ < mx_) { ConvJob J{INP(14), ODD_IN, ODD_IN, INP(20), INP(25), INP(27), WS_W1OFF}; convert_queue(F, J, (int*)(WSP() + WS_CTL) + CW_CONV, (mx_ - my_) * TAIL_BATCHES); } }
        GRID_BAR();
        PHASE_BEGIN();
        { unsigned char* ws = WSP(); pg8::MoeSched S; S.A = (const char*)(ws + WS_ACT); S.Bt = (const char*)(ws + WOFF + WS_WDN); S.slot_tok = (const int*)(ws + WS_SLOT); S.tile_e = TILE_E; S.tile_f = TILE_F; S.ecnt = ECNT;
          S.NPN = 4; S.n_units = ntile * 4; S.G = F.G; S.c = F.bx; S.bexp = (size_t)D_ * DFF * 2; S.gather = false;
          pg8::EpiBias E{(bf16_t*)(ws + WS_YA), INP(11 + lb), TILE_E};
          pg8::gemm_phase<pg8::EpiBias, pg8::MoeSched, false>(F.lds, DFF, S, E, F.tid); }
        if (layer == 0) { pg8::MoeSched S_; S_.NPN = 4; S_.n_units = ntile * 4; S_.G = F.G; S_.c = F.bx; const int nu_ = ntile * 4, my_ = S_.my_units(), mx_ = (nu_ + F.G - 1) / F.G;
          if (my_ < mx_) { ConvJob J{INP(14), ODD_IN, ODD_IN, INP(20), INP(25), INP(27), WS_W1OFF}; convert_queue(F, J, (int*)(WSP() + WS_CTL) + CW_CONV, (mx_ - my_) * TAIL_BATCHES); } }
        GRID_BAR();
        PHASE_BEGIN();
        { unsigned char* ws = WSP();
          combine_ln_phase(F, (const bf16_t*)(ws + WS_X1B), (const bf16_t*)(ws + WS_YA), (const int*)(ws + WS_TKE), (const int*)(ws + WS_TKR), (const float*)(ws + WS_TKG),
                           INP(12 + lb), INP(13 + lb), layer == 0 ? (float*)nullptr : OUTP(), layer == 0 ? (bf16_t*)(ws + WS_XB) : nullptr); }
        if (layer == 0) {
            __syncthreads();
            PHASE_BEGIN();
            { ConvJob J{INP(14), ODD_IN, ODD_IN, INP(20), INP(25), INP(27), WS_W1OFF}; convert_queue(F, J, (int*)(WSP() + WS_CTL) + CW_CONV, 1 << 30, 1); }
            GRID_BAR();
        }
}

__global__ void __launch_bounds__(NTHR, 2) mega_fwd(Args args) {
    extern __shared__ __attribute__((aligned(16))) unsigned char lds_raw[];
    Frame F;
    F.lds = (LAS unsigned char*)lds_raw;
    F.tid = threadIdx.x; F.lane = F.tid & 63; F.wave = __builtin_amdgcn_readfirstlane(F.tid >> 6);
    F.G = gridDim.x; F.bx = blockIdx.x; { const int bx = blockIdx.x; F.vcu = (F.G % 8 == 0) ? (bx % 8) * (F.G / 8) + bx / 8 : bx; }
    F.gw = F.vcu * NWAVES + F.wave; F.NGW = F.G * NWAVES;
    for (int u = F.tid; u < (LDS_BYTES - CTL_OFF) / 4; u += NTHR) ((LAS unsigned*)(F.lds + CTL_OFF))[u] = 0u;
    __syncthreads();
    if (F.tid == 0) {
        LAS unsigned long long* pt = (LAS unsigned long long*)(F.lds + PTAB_OFF);
#pragma unroll
        for (int i = 0; i < 31; ++i) pt[i] = (unsigned long long)args.in[i];
        pt[31] = (unsigned long long)args.out; pt[32] = (unsigned long long)args.ws;
    }
    __syncthreads();
    F.ws = WSP();
    XcdBarrier bar = xcd_barrier_post((unsigned*)(WSP() + WS_CTL) + CW_BAR, (volatile LAS unsigned*)(F.lds + MISC_OFF) + 8);

    { ConvJob J{INP(1), EVEN_IN, EVEN_PAD, INP(3), INP(8), INP(10), 0}; convert_weights(F, J, 16 * (EVEN_PAD / 64) + 256); }
    convert_x(F, INP(0), (bf16_t*)(WSP() + WS_XB));
    if (gridDim.x == 0x7fffffffu) cg::this_grid().sync();
    GRID_BAR();

    run_layer<0>(F, bar);
    run_layer<1>(F, bar);
}

extern "C" void kernel_launch(void* const* d_in, const int* in_sizes, int n_in, void* d_out, int out_size, void* d_ws, size_t ws_size, hipStream_t stream) {
    (void)in_sizes; (void)out_size;
    static int grid = 0;
    if (grid == 0) {
        if (n_in != 31 || ws_size < WS_END) { fprintf(stderr, "kernel_launch: unexpected n_in %d or ws_size %zu\n", n_in, ws_size); grid = -1; return; }
        int dev = 0, cus = 0, per_cu = 0;
        if (hipGetDevice(&dev) != hipSuccess || hipDeviceGetAttribute(&cus, hipDeviceAttributeMultiprocessorCount, dev) != hipSuccess) { grid = -1; return; }
        if (hipFuncSetAttribute((const void*)mega_fwd, hipFuncAttributeMaxDynamicSharedMemorySize, LDS_BYTES) != hipSuccess) { fprintf(stderr, "kernel_launch: hipFuncSetAttribute failed\n"); grid = -1; return; }
        if (hipOccupancyMaxActiveBlocksPerMultiprocessor(&per_cu, (const void*)mega_fwd, NTHR, LDS_BYTES) != hipSuccess || per_cu < 1) { fprintf(stderr, "kernel_launch: occupancy query says %d\n", per_cu); per_cu = 1; }
        (void)hipGetLastError();
        grid = cus;
    }
    if (grid < 0) return;
    if (hipMemsetAsync((char*)d_ws + WS_CTL, 0, CTL_ZERO_BYTES, stream) != hipSuccess) return;
    Args a{};
    for (int i = 0; i < 31; ++i) a.in[i] = (const float*)d_in[i];
    a.out = (float*)d_out; a.ws = (unsigned char*)d_ws;
    void* kargs[] = {&a};
    hipError_t e = hipLaunchCooperativeKernel((const void*)mega_fwd, dim3(grid), dim3(NTHR), kargs, LDS_BYTES, stream);
    if (e != hipSuccess) fprintf(stderr, "kernel_launch: cooperative launch failed: %s (grid %d)\n", hipGetErrorString(e), grid);
}
```

```cpp
#include <hip/hip_runtime.h>
#include <hip/hip_cooperative_groups.h>
#include <cstdio>
#include <cstdint>
#include <cmath>
namespace cg = cooperative_groups;

#define LAS __attribute__((address_space(3)))
#define GAS __attribute__((address_space(1)))
typedef unsigned short bf16_t;
typedef short bf16x8 __attribute__((ext_vector_type(8)));
typedef float f32x4 __attribute__((ext_vector_type(4)));
typedef float f32x2 __attribute__((ext_vector_type(2)));
typedef unsigned u32x4 __attribute__((ext_vector_type(4)));
typedef unsigned u32x2 __attribute__((ext_vector_type(2)));

constexpr int B_ = 4, S_ = 4096, D_ = 1024, NTOK = B_ * S_;
constexpr int EVEN_IN = 3368, EVEN_PAD = 3584, ODD_IN = 3072;
constexpr int NE = 32, TOPK = 4, DFF = 1024;
constexpr float ALPHA = 1.41421356237f;
constexpr float LN_EPS = 1e-5f, RMS_EPS = 1e-5f;
constexpr int MAXTILES = NTOK * TOPK / 256 + NE;
constexpr int MAXROWS = MAXTILES * 256;
constexpr int E_GB = 0, E_GC = 512, E_XA = 1024, E_Q = 1536, E_K = 2048, E_V = 2560, E_IQ = 3072, E_IK = 3328, E_IW = 3360;
constexpr int O_QC = 0, O_KC = 512, O_VC = 1024, O_QD = 1536, O_KD = 2048, O_VD = 2560;
constexpr int NWAVES = 8, NTHR = 512;

constexpr size_t MiB = 1u << 20;
constexpr size_t WS_CTL = 0, CTL_ZERO_BYTES = 1 * MiB;
constexpr size_t WS_SLOT = 2 * MiB;
constexpr size_t WS_TKE = 4 * MiB, WS_TKR = 5 * MiB, WS_TKG = 6 * MiB;
constexpr size_t WS_WIN = 8 * MiB, WS_WOUT = 16 * MiB, WS_WGU = 18 * MiB, WS_WDN = 146 * MiB;
constexpr size_t WS_XB = 210 * MiB;
constexpr size_t WS_H = 242 * MiB;
constexpr size_t WS_Y = 354 * MiB;
constexpr size_t WS_MB = 386 * MiB;
constexpr size_t WS_ACT = 242 * MiB;
constexpr size_t WS_YA = 418 * MiB;
constexpr size_t WS_X1 = 562 * MiB;
constexpr size_t WS_X1B = 626 * MiB;
constexpr size_t WS_X2 = 658 * MiB;
constexpr size_t WS_W1OFF = 714 * MiB;
constexpr size_t WS_END = 924 * MiB;
constexpr int CW_BAR = 4096;
constexpr int CW_CONV = 80000;
constexpr int CW_BCNT = 65536;

constexpr int RING_BYTES = 131072;
constexpr int CTL_OFF = RING_BYTES, MISC_OFF = CTL_OFF + 320, TILE_E_OFF = CTL_OFF + 1024, TILE_F_OFF = CTL_OFF + 2304, EBASE_OFF = CTL_OFF + 3584, ECNT_OFF = CTL_OFF + 3744;
constexpr int ROUTE_OFF = CTL_OFF + 6144;
constexpr int LDS_BYTES = 147456;

#define LDS_WAIT() asm volatile("s_waitcnt lgkmcnt(0)" ::: "memory")
#define VM_WAIT() asm volatile("s_waitcnt vmcnt(0)" ::: "memory")
__device__ __forceinline__ unsigned f2bf(float f) { unsigned u = __builtin_bit_cast(unsigned, f); return (u + 0x7fffu + ((u >> 16) & 1u)) >> 16; }
__device__ __forceinline__ unsigned pk2(float lo, float hi) { return f2bf(lo) | (f2bf(hi) << 16); }
__device__ __forceinline__ float bf2f(unsigned h) { return __builtin_bit_cast(float, h << 16); }
__device__ __forceinline__ float bflo(unsigned w) { return __builtin_bit_cast(float, w << 16); }
__device__ __forceinline__ float bfhi(unsigned w) { return __builtin_bit_cast(float, w & 0xffff0000u); }
__device__ __forceinline__ float wave_sum(float v) {
#pragma unroll
    for (int o = 1; o < 64; o <<= 1) v += __shfl_xor(v, o);
    return v;
}
__device__ __forceinline__ float wave_max(float v) {
#pragma unroll
    for (int o = 1; o < 64; o <<= 1) v = fmaxf(v, __shfl_xor(v, o));
    return v;
}
template <int CTRL, int ROWMASK> __device__ __forceinline__ float dpp_mov(float v, float old) { return __builtin_bit_cast(float, __builtin_amdgcn_update_dpp(__builtin_bit_cast(int, old), __builtin_bit_cast(int, v), CTRL, ROWMASK, 0xF, false)); }
__device__ __forceinline__ float wave_sum_u(float v) {
    v += dpp_mov<0xB1, 0xF>(v, 0.f); v += dpp_mov<0x4E, 0xF>(v, 0.f); v += dpp_mov<0x141, 0xF>(v, 0.f); v += dpp_mov<0x140, 0xF>(v, 0.f);
    v += dpp_mov<0x142, 0xA>(v, 0.f); v += dpp_mov<0x143, 0xC>(v, 0.f);
    return __builtin_bit_cast(float, __builtin_amdgcn_readlane(__builtin_bit_cast(int, v), 63));
}
__device__ __forceinline__ float wave_max_u(float v) {
    const float ninf = -INFINITY;
    v = fmaxf(v, dpp_mov<0xB1, 0xF>(v, ninf)); v = fmaxf(v, dpp_mov<0x4E, 0xF>(v, ninf)); v = fmaxf(v, dpp_mov<0x141, 0xF>(v, ninf)); v = fmaxf(v, dpp_mov<0x140, 0xF>(v, ninf));
    v = fmaxf(v, dpp_mov<0x142, 0xA>(v, ninf)); v = fmaxf(v, dpp_mov<0x143, 0xC>(v, ninf));
    return __builtin_bit_cast(float, __builtin_amdgcn_readlane(__builtin_bit_cast(int, v), 63));
}
__device__ __forceinline__ int wave_sum_iu(int v) {
#define DPPI(x, C, M) __builtin_amdgcn_update_dpp(0, (x), C, M, 0xF, false)
    v += DPPI(v, 0xB1, 0xF); v += DPPI(v, 0x4E, 0xF); v += DPPI(v, 0x141, 0xF); v += DPPI(v, 0x140, 0xF); v += DPPI(v, 0x142, 0xA); v += DPPI(v, 0x143, 0xC);
#undef DPPI
    return __builtin_amdgcn_readlane(v, 63);
}
__device__ __forceinline__ unsigned cvt_pk_bf16(float lo, float hi) { unsigned r; asm volatile("v_cvt_pk_bf16_f32 %0, %1, %2" : "=v"(r) : "v"(lo), "v"(hi)); return r; }

__device__ __forceinline__ int fresh_lane() { int o_ = -1; asm volatile("" : "+v"(o_)); const unsigned m_ = (unsigned)__builtin_amdgcn_readfirstlane(o_); return (int)__builtin_amdgcn_mbcnt_hi(m_, __builtin_amdgcn_mbcnt_lo(m_, 0u)); }
namespace pg8 {
constexpr int BM = 256, BK = 64, HALF = 128, HTB = HALF * BK * 2, STAGE_BYTES = 8 * HTB, NXCD = 8, WGM = 8;
__host__ __device__ __forceinline__ int lds_byte(int r, int c) { const int st = (r >> 4) * 2 + (c >> 5), rr = r & 15, cc = c & 31, ob = rr * 64 + cc * 2; return st * 1024 + (ob ^ (((ob >> 9) & 1) << 5)); }
__host__ __device__ __forceinline__ void stage_rc(int b, int& R, int& C) { const int st = b / 1024, sb = b % 1024, swz = sb ^ (((sb >> 9) & 1) << 5); R = (st >> 1) * 16 + swz / 64; C = (st & 1) * 32 + (swz % 64) / 2; }
__host__ __device__ __forceinline__ int perm32(int rho) { const int n = rho >> 4, i = rho & 15; return 8 * (i >> 2) + 4 * n + (i & 3); }
struct Unit { int pm, pn; };

struct DenseSched {
    const char* A; const char* Bt; int nM, nN, nwg, G, c; size_t tstep;
    __device__ void init(const void* A_, const void* Bt_, int M, int N, int K, int G_, int c_) { A = (const char*)A_; Bt = (const char*)Bt_; nM = M / BM; nN = N / BM; nwg = nM * nN; G = G_; c = c_; tstep = (size_t)BM * K * 2; }
    __device__ bool next(int i, Unit& u) const {
        const long L = (long)i * G + c; if (L >= nwg) return false;
        int wgid = (int)L; { const int q = nwg / NXCD, r = nwg % NXCD, xcd = wgid % NXCD, off = wgid / NXCD; wgid = (xcd < r ? xcd * (q + 1) : r * (q + 1) + (xcd - r) * q) + off; }
        const int nig = WGM * nN, gid = wgid / nig, fm = gid * WGM, gsz = (nM - fm) < WGM ? (nM - fm) : WGM;
        u.pm = fm + ((wgid % nig) % gsz); u.pn = (wgid % nig) / gsz; return true;
    }
    __device__ __forceinline__ const char* a_base(const Unit& u) const { return A + (size_t)u.pm * tstep; }
    __device__ __forceinline__ const char* b_base(const Unit& u) const { return Bt + (size_t)u.pn * tstep; }
    __device__ __forceinline__ unsigned row_off(const Unit&, int) const { return 0u; }
};
struct MoeSched {
    const char* A; const char* Bt; const int* slot_tok; const LAS int* tile_e; const LAS int* tile_f; const LAS int* ecnt;
    int n_units, NPN, G, c; size_t bexp; bool gather;
    __device__ __forceinline__ int tile_off() const { return (c % NXCD) * (G / NXCD / NPN) + (c / NXCD) / NPN; }
    __device__ bool next(int i, Unit& u) const {
        if (G % (NXCD * NPN) != 0) { const long L = (long)i * G + c; if (L >= n_units) return false; u.pm = (int)(L / NPN); u.pn = (int)(L % NPN); return true; }
        const int pm = i * (G / NPN) + tile_off(); if (pm >= n_units / NPN) return false; u.pm = pm; u.pn = (c / NXCD) % NPN; return true; }
    __device__ __forceinline__ int my_units() const { if (G % (NXCD * NPN) != 0) return (int)((n_units - c + G - 1) / G); const int nt_ = n_units / NPN, o = tile_off(), tpr = G / NPN; return o < nt_ ? (nt_ - o + tpr - 1) / tpr : 0; }
    __device__ __forceinline__ const char* a_base(const Unit& u) const { return gather ? A : A + (size_t)u.pm * ((size_t)BM * 1024 * 2); }
    __device__ __forceinline__ const char* b_base(const Unit& u) const { return Bt + (size_t)tile_e[u.pm] * bexp + (size_t)u.pn * ((size_t)BM * 1024 * 2); }
    __device__ __forceinline__ unsigned row_off(const Unit& u, int r) const {
        const int e = tile_e[u.pm], rk = tile_f[u.pm] * BM + r; const int tok = rk < ecnt[e] ? slot_tok[e * NTOK + rk] : 0;
        return (unsigned)tok * 2048u;
    }
};

struct EpiBf16 {
    static constexpr bool PERM = true;
    bf16_t* O; int ldc;
    __device__ __forceinline__ void operator()(const f32x4 (&acc)[2][2][4][2], const Unit& u, int wr, int wc, int fr, int fq) const {
        const int row0 = u.pm * BM + wr * 64 + fr, col0 = u.pn * BM + wc * 32 + 8 * fq;
#pragma unroll
        for (int ai = 0; ai < 2; ++ai)
#pragma unroll
            for (int m = 0; m < 4; ++m) { bf16_t* rowp = O + (size_t)(row0 + ai * HALF + m * 16) * ldc + col0;
#pragma unroll
                for (int bj = 0; bj < 2; ++bj) { const f32x4 v0 = acc[ai][bj][m][0], v1 = acc[ai][bj][m][1];
                    u32x4 w; w.x = cvt_pk_bf16(v0[0], v0[1]); w.y = cvt_pk_bf16(v0[2], v0[3]); w.z = cvt_pk_bf16(v1[0], v1[1]); w.w = cvt_pk_bf16(v1[2], v1[3]);
                    *(u32x4*)(rowp + bj * HALF) = w; } }
    }
};
struct EpiAct {
    static constexpr bool PERM = true;
    bf16_t* O; const float* bias; const LAS int* tile_e;
    __device__ __forceinline__ void operator()(const f32x4 (&acc)[2][2][4][2], const Unit& u, int wr, int wc, int fr, int fq) const {
        const int e = tile_e[u.pm];
        const float* bg = bias + (size_t)e * 2 * DFF + u.pn * HALF + wc * 32 + 8 * fq;
        const f32x4 bg0 = *(const f32x4*)bg, bg1 = *(const f32x4*)(bg + 4), bu0 = *(const f32x4*)(bg + DFF), bu1 = *(const f32x4*)(bg + DFF + 4);
        const int row0 = u.pm * BM + wr * 64 + fr, col0 = u.pn * HALF + wc * 32 + 8 * fq;
#pragma unroll
        for (int ai = 0; ai < 2; ++ai)
#pragma unroll
            for (int m = 0; m < 4; ++m) {
                f32x4 g0 = acc[ai][0][m][0] + bg0, g1 = acc[ai][0][m][1] + bg1, u0 = acc[ai][1][m][0] + bu0, u1 = acc[ai][1][m][1] + bu1;
                float r[8];
#pragma unroll
                for (int j = 0; j < 8; ++j) { float gt = j < 4 ? g0[j & 3] : g1[j & 3], up = j < 4 ? u0[j & 3] : u1[j & 3];
                    gt = fminf(gt, 7.0f); up = fminf(fmaxf(up, -7.0f), 7.0f);
                    const float sg = __builtin_amdgcn_rcpf(1.0f + __builtin_amdgcn_exp2f(-1.702f * 1.4426950408889634f * gt));
                    r[j] = (up + 1.0f) * (gt * sg); }
                u32x4 w; w.x = cvt_pk_bf16(r[0], r[1]); w.y = cvt_pk_bf16(r[2], r[3]); w.z = cvt_pk_bf16(r[4], r[5]); w.w = cvt_pk_bf16(r[6], r[7]);
                *(u32x4*)(O + (size_t)(row0 + ai * HALF + m * 16) * DFF + col0) = w; }
    }
};
struct EpiBias {
    static constexpr bool PERM = true;
    bf16_t* O; const float* bias; const LAS int* tile_e;
    __device__ __forceinline__ void operator()(const f32x4 (&acc)[2][2][4][2], const Unit& u, int wr, int wc, int fr, int fq) const {
        const int e = tile_e[u.pm];
        const int row0 = u.pm * BM + wr * 64 + fr, col0 = u.pn * BM + wc * 32 + 8 * fq;
        const float* bp = bias + (size_t)e * D_ + col0;
        f32x4 bv[2][2];
#pragma unroll
        for (int bj = 0; bj < 2; ++bj)
#pragma unroll
            for (int n = 0; n < 2; ++n) bv[bj][n] = *(const f32x4*)(bp + bj * HALF + 4 * n);
#pragma unroll
        for (int ai = 0; ai < 2; ++ai)
#pragma unroll
            for (int m = 0; m < 4; ++m) { bf16_t* rowp = O + (size_t)(row0 + ai * HALF + m * 16) * D_ + col0;
#pragma unroll
                for (int bj = 0; bj < 2; ++bj) { const f32x4 v0 = acc[ai][bj][m][0] + bv[bj][0], v1 = acc[ai][bj][m][1] + bv[bj][1];
                    u32x4 w; w.x = cvt_pk_bf16(v0[0], v0[1]); w.y = cvt_pk_bf16(v0[2], v0[3]); w.z = cvt_pk_bf16(v1[0], v1[1]); w.w = cvt_pk_bf16(v1[2], v1[3]);
                    *(u32x4*)(rowp + bj * HALF) = w; } }
    }
};

template <class Epi, class Sched, bool GATHER>
__device__ __forceinline__ void gemm_phase(LAS unsigned char* lds, const int K, const Sched& S, const Epi& E, const int tid) {
    const int wid = __builtin_amdgcn_readfirstlane(tid >> 6), lane = tid & 63, wr = wid >> 2, wc = wid & 3, fr = lane & 15, fq = lane >> 4;
    const int nt = K / BK;
    unsigned voffA[2], voffB[2]; int RA[2], CA2[2];
#pragma unroll
    for (int i = 0; i < 2; ++i) { int R, C; stage_rc(tid * 16 + i * 8192, R, C); const int Rb = Epi::PERM ? ((R & ~31) + perm32(R & 31)) : R;
        voffA[i] = (unsigned)(R * K + C) * 2u; voffB[i] = (unsigned)(Rb * K + C) * 2u; RA[i] = R; CA2[i] = C * 2; }
    const size_t kstep = (size_t)(BK * 2);
    const size_t hstep = (size_t)HALF * K * 2;
    const unsigned ldsw = (unsigned)wid * 1024u;
    const int aoff = lds_byte(wr * 64 + fr, fq * 8), boff = lds_byte(wc * 32 + fr, fq * 8);
#define PG8_SA(b, h) (((b) * 2 + (h)) * HTB)
#define PG8_SB(b, h) ((4 + (b) * 2 + (h)) * HTB)
#define PG8_STAGE(bufoff, gbase, voff) do { _Pragma("unroll") for (int _i = 0; _i < 2; ++_i) \
        __builtin_amdgcn_global_load_lds((const unsigned*)((const char*)(gbase) + (voff)[_i]), (LAS unsigned*)(lds + (bufoff) + ldsw + _i * 8192), 16, 0, 0); } while (0)
#define PG8_STAGE_A(bufoff, gbase, h, vg) do { if constexpr (GATHER) { PG8_STAGE(bufoff, gbase, (vg)[h]); } else { PG8_STAGE(bufoff, (gbase) + (h) * hstep, voffA); } } while (0)
#define PG8_LDA(dst, b, h) do { _Pragma("unroll") for (int m = 0; m < 4; ++m) _Pragma("unroll") for (int k = 0; k < 2; ++k) dst[m][k] = *(const LAS bf16x8*)(lds + PG8_SA(b, h) + aoff + m * 2048 + k * 1024); } while (0)
#define PG8_LDB(dst, b, h) do { _Pragma("unroll") for (int n = 0; n < 2; ++n) _Pragma("unroll") for (int k = 0; k < 2; ++k) dst[n][k] = *(const LAS bf16x8*)(lds + PG8_SB(b, h) + boff + n * 2048 + k * 1024); } while (0)
#define PG8_MMA(ai, bj, At, Bt) do { __builtin_amdgcn_s_setprio(1); _Pragma("unroll") for (int m = 0; m < 4; ++m) _Pragma("unroll") for (int n = 0; n < 2; ++n) _Pragma("unroll") for (int k = 0; k < 2; ++k) \
        acc[ai][bj][m][n] = __builtin_amdgcn_mfma_f32_16x16x32_bf16(Bt[n][k], At[m][k], acc[ai][bj][m][n], 0, 0, 0); __builtin_amdgcn_s_setprio(0); } while (0)
#define PG8_WAIT_V(n) asm volatile("s_waitcnt vmcnt(" #n ")" ::: "memory")
#define PG8_WAIT_L(n) asm volatile("s_waitcnt lgkmcnt(" #n ")" ::: "memory")
#define PG8_BAR __builtin_amdgcn_s_barrier()
#define PG8_SCHED __builtin_amdgcn_sched_barrier(0)
    Unit cur, nxt; int ui = 0;
    if (!S.next(0, cur)) return;
    f32x4 acc[2][2][4][2];
#pragma unroll
    for (int a = 0; a < 2; ++a)
#pragma unroll
        for (int b = 0; b < 2; ++b)
#pragma unroll
            for (int m = 0; m < 4; ++m)
#pragma unroll
                for (int n = 0; n < 2; ++n) acc[a][b][m][n] = (f32x4){0.f, 0.f, 0.f, 0.f};
    bf16x8 At[4][2], B0[2][2], B1[2][2];
    unsigned vgc[2][2] = {{0u, 0u}, {0u, 0u}}, vgn[2][2] = {{0u, 0u}, {0u, 0u}};
    if constexpr (GATHER) {
#pragma unroll
        for (int h = 0; h < 2; ++h)
#pragma unroll
            for (int i = 0; i < 2; ++i) vgc[h][i] = S.row_off(cur, h * HALF + RA[i]) + (unsigned)CA2[i];
    }
    const char* cA = S.a_base(cur); const char* cB = S.b_base(cur);
    PG8_STAGE(PG8_SB(0, 0), cB, voffB); PG8_STAGE(PG8_SB(0, 1), cB + hstep, voffB); PG8_STAGE_A(PG8_SA(0, 0), cA, 0, vgc); PG8_STAGE_A(PG8_SA(0, 1), cA, 1, vgc);
    if (wr == 1) PG8_BAR;
    PG8_WAIT_V(2); PG8_BAR;
    PG8_STAGE(PG8_SB(1, 0), cB + kstep, voffB); PG8_STAGE_A(PG8_SA(1, 0), cA + kstep, 0, vgc); PG8_STAGE(PG8_SB(1, 1), cB + hstep + kstep, voffB);
    PG8_WAIT_V(6); PG8_BAR;
    for (;;) {
        const bool has_next = S.next(ui + 1, nxt);
        const char* nA = has_next ? S.a_base(nxt) : cA; const char* nB = has_next ? S.b_base(nxt) : cB;
        if constexpr (GATHER) {
            if (has_next) {
#pragma unroll
                for (int h = 0; h < 2; ++h)
#pragma unroll
                    for (int i = 0; i < 2; ++i) vgn[h][i] = S.row_off(nxt, h * HALF + RA[i]) + (unsigned)CA2[i];
            } else {
#pragma unroll
                for (int h = 0; h < 2; ++h)
#pragma unroll
                    for (int i = 0; i < 2; ++i) vgn[h][i] = vgc[h][i];
            }
        }
        for (int t = 0; t < nt; t += 2) {
            const bool last = (t == nt - 2);
            const char* a1 = cA + (size_t)(t + 1) * kstep;
            const char* a2 = last ? nA : cA + (size_t)(t + 2) * kstep; const char* b2 = last ? nB : cB + (size_t)(t + 2) * kstep;
            const char* a3 = a2 + kstep; const char* b3 = b2 + kstep;
            unsigned vg2[2][2];
#pragma unroll
            for (int h = 0; h < 2; ++h)
#pragma unroll
                for (int i = 0; i < 2; ++i) vg2[h][i] = last ? vgn[h][i] : vgc[h][i];
            PG8_LDB(B0, 0, 0); PG8_LDB(B1, 0, 1); PG8_SCHED; PG8_LDA(At, 0, 0); PG8_STAGE_A(PG8_SA(1, 1), a1, 1, vgc);
            PG8_WAIT_V(8); PG8_WAIT_L(0); PG8_BAR; PG8_MMA(0, 0, At, B0); PG8_MMA(0, 1, At, B1); PG8_BAR; PG8_SCHED;
            PG8_LDA(At, 0, 1); PG8_STAGE(PG8_SB(0, 0), b2, voffB); PG8_STAGE(PG8_SB(0, 1), b2 + hstep, voffB); PG8_STAGE_A(PG8_SA(0, 0), a2, 0, vg2);
            PG8_WAIT_V(8); PG8_WAIT_L(0); PG8_BAR; PG8_MMA(1, 0, At, B0); PG8_MMA(1, 1, At, B1); PG8_BAR; PG8_SCHED;
            PG8_LDB(B0, 1, 0); PG8_LDB(B1, 1, 1); PG8_SCHED; PG8_LDA(At, 1, 0); PG8_STAGE_A(PG8_SA(0, 1), a2, 1, vg2);
            PG8_WAIT_V(8); PG8_WAIT_L(0); PG8_BAR; PG8_MMA(0, 0, At, B0); PG8_MMA(0, 1, At, B1); PG8_BAR; PG8_SCHED;
            PG8_LDA(At, 1, 1); PG8_STAGE(PG8_SB(1, 0), b3, voffB); PG8_STAGE(PG8_SB(1, 1), b3 + hstep, voffB); PG8_STAGE_A(PG8_SA(1, 0), a3, 0, vg2);
            PG8_WAIT_V(8); PG8_WAIT_L(0); PG8_BAR; PG8_MMA(1, 0, At, B0); PG8_MMA(1, 1, At, B1); PG8_BAR; PG8_SCHED;
        }
        if (wr == 0) PG8_BAR;
        E(acc, cur, wr, wc, fr, fq);
        if (!has_next) break;
#pragma unroll
        for (int a = 0; a < 2; ++a)
#pragma unroll
            for (int b = 0; b < 2; ++b)
#pragma unroll
                for (int m = 0; m < 4; ++m)
#pragma unroll
                    for (int n = 0; n < 2; ++n) acc[a][b][m][n] = (f32x4){0.f, 0.f, 0.f, 0.f};
        cur = nxt; cA = nA; cB = nB; ++ui;
        if constexpr (GATHER) {
#pragma unroll
            for (int h = 0; h < 2; ++h)
#pragma unroll
                for (int i = 0; i < 2; ++i) vgc[h][i] = vgn[h][i];
        }
        if (wr == 1) PG8_BAR;
    }
    PG8_WAIT_V(0);
    PG8_BAR;
#undef PG8_SA
#undef PG8_SB
#undef PG8_STAGE
#undef PG8_STAGE_A
#undef PG8_LDA
#undef PG8_LDB
#undef PG8_MMA
#undef PG8_WAIT_V
#undef PG8_WAIT_L
#undef PG8_BAR
#undef PG8_SCHED
}
}

#define XB_TMO      128
#define XB_XCNT(j)  (256  + 64 * (j))
#define XB_XSUB(j)  (1280 + 64 * (j))
#define XB_XGEN(j)  (2304 + 64 * (j))
#define XB_TOP      3328
#define XB_TOPGEN   3392
#define XCD_BAR_WORDS 3456
#define XB_SPIN_CAP (1u << 18)
__device__ __forceinline__ unsigned xb_ld(unsigned* p)              { return __hip_atomic_load(p, __ATOMIC_RELAXED, __HIP_MEMORY_SCOPE_AGENT); }
__device__ __forceinline__ unsigned xb_add(unsigned* p, unsigned v) { return __hip_atomic_fetch_add(p, v, __ATOMIC_RELAXED, __HIP_MEMORY_SCOPE_AGENT); }
__device__ __forceinline__ unsigned xb_xcc_id() { return (unsigned)__builtin_amdgcn_s_getreg((3 << 11) | 20) & 0xFu; }
#define XB_SPIN(cond, bar) do { unsigned _sp = 0; while (cond) { __builtin_amdgcn_s_sleep(1); \
    if ((++_sp & 255u) == 0u) { if (xb_ld(&(bar)[XB_TMO])) break; if (_sp > XB_SPIN_CAP) { atomicAdd(&(bar)[XB_TMO], 1u); break; } } } } while (0)
struct XcdBarrier { unsigned* bar; unsigned x; volatile LAS unsigned* st; };
__device__ __forceinline__ XcdBarrier xcd_barrier_post(unsigned* bar, volatile LAS unsigned* st) {
    XcdBarrier b; b.bar = bar; b.x = xb_xcc_id(); b.st = st;
    if (threadIdx.x == 0) (void)xb_add(&bar[XB_XCNT(b.x)], 1u);
    return b;
}
__device__ __forceinline__ void xcd_barrier_complete(unsigned* bar, unsigned x, unsigned& nloc, unsigned& nx) {
    const unsigned G = gridDim.x * gridDim.y * gridDim.z;
    unsigned sum, cnt, mine, sp = 0u;
    for (;;) {
        sum = 0u; cnt = 0u; mine = 0u;
#pragma unroll
        for (unsigned j = 0; j < 16; ++j) { const unsigned c = xb_ld(&bar[XB_XCNT(j)]); sum += c; cnt += (c > 0u) ? 1u : 0u; mine = (j == x) ? c : mine; }
        if (sum == G) break;
        __builtin_amdgcn_s_sleep(1);
        if ((++sp & 255u) == 0u) { if (xb_ld(&bar[XB_TMO])) break; if (sp > XB_SPIN_CAP) { atomicAdd(&bar[XB_TMO], 1u); break; } }
    }
    nloc = mine > 0u ? mine : 1u; nx = cnt > 0u ? cnt : 1u;
}
__device__ __forceinline__ void xcd_barrier(const XcdBarrier& b, const bool leader) {
    asm volatile("s_waitcnt vmcnt(0)" ::: "memory");
    __syncthreads();
    if (leader) {
        unsigned* bar = b.bar; unsigned bx_ = b.x;
        asm volatile("" : "+s"(bar), "+s"(bx_));
        __builtin_amdgcn_s_waitcnt(0);
        unsigned nloc = b.st[0], nx = b.st[1];
        if (nloc == 0u) { xcd_barrier_complete(bar, bx_, nloc, nx); b.st[0] = nloc; b.st[1] = nx; }
        const unsigned old = xb_add(&bar[XB_XSUB(bx_)], 1u);
        const unsigned gen = old / nloc;
        if (old + 1u == (gen + 1u) * nloc) {
            __builtin_amdgcn_fence(__ATOMIC_RELEASE, "agent");
            asm volatile("s_waitcnt vmcnt(0)" ::: "memory");
            const unsigned og = xb_add(&bar[XB_TOP], 1u);
            const unsigned tg = og / nx;
            if (og + 1u == (tg + 1u) * nx) xb_add(&bar[XB_TOPGEN], 1u);
            else XB_SPIN(xb_ld(&bar[XB_TOPGEN]) == tg, bar);
            __builtin_amdgcn_fence(__ATOMIC_ACQUIRE, "agent");
            xb_add(&bar[XB_XGEN(bx_)], 1u);
            asm volatile("s_waitcnt vmcnt(0)" ::: "memory");
        } else {
            XB_SPIN(xb_ld(&bar[XB_XGEN(bx_)]) == gen, bar);
            __builtin_amdgcn_fence(__ATOMIC_ACQUIRE, "agent");
            asm volatile("s_waitcnt vmcnt(0)" ::: "memory");
        }
    }
    __syncthreads();
}

struct Args { const float* in[31]; float* out; unsigned char* ws; };
struct Frame {
    LAS unsigned char* lds;
    int tid, lane, wave, vcu, G, gw, NGW, bx;
    unsigned char* ws;
};

__device__ __forceinline__ void transpose_item64(const float* W, int ld, bf16_t* WT, int k0, int n0, int c0, int nvalid, int lane) {
    const float* src = W + (size_t)k0 * ld + c0 + lane; const bool ok = lane < nvalid;
    float v[64];
#pragma unroll
    for (int i = 0; i < 64; ++i) v[i] = ok ? src[(size_t)i * ld] : 0.f;
    u32x4* dst = (u32x4*)(WT + (size_t)(n0 + lane) * 1024 + k0);
#pragma unroll
    for (int j = 0; j < 8; ++j) { u32x4 o; o.x = pk2(v[8 * j], v[8 * j + 1]); o.y = pk2(v[8 * j + 2], v[8 * j + 3]); o.z = pk2(v[8 * j + 4], v[8 * j + 5]); o.w = pk2(v[8 * j + 6], v[8 * j + 7]); dst[j] = o; }
}
struct ConvJob { const float* w_in; int nin, npad; const float* w_out; const float* w_gu; const float* w_dn; size_t woff; };
__device__ __forceinline__ int conv_nitems(const ConvJob& J) { return 16 * (J.npad / 64) + 16 * 16 + NE * 16 * 32 + NE * 16 * 16; }
__device__ __forceinline__ void convert_item(const Frame& F, const ConvJob& J, int it) {
    bf16_t* WIN = (bf16_t*)(F.ws + J.woff + WS_WIN); bf16_t* WOUT = (bf16_t*)(F.ws + J.woff + WS_WOUT); bf16_t* WGU = (bf16_t*)(F.ws + J.woff + WS_WGU); bf16_t* WDN = (bf16_t*)(F.ws + J.woff + WS_WDN);
    const int I_IN = 16 * (J.npad / 64), I_OUT = 16 * 16, I_GU = NE * 16 * 32;
    const int lane = fresh_lane();
    int r = it;
    if (r < I_IN) { const int nblk = J.npad / 64, kb = r / nblk, nb = r % nblk; const int c0 = nb * 64; int nv = J.nin - c0; nv = nv < 0 ? 0 : (nv > 64 ? 64 : nv);
        transpose_item64(J.w_in, J.nin, WIN, kb * 64, nb * 64, c0, nv, lane); return; }
    r -= I_IN;
    if (r < I_OUT) { const int kb = r / 16, nb = r % 16; transpose_item64(J.w_out, D_, WOUT, kb * 64, nb * 64, nb * 64, 64, lane); return; }
    r -= I_OUT;
    if (r < I_GU) { const int e = r / (16 * 32), rr = r % (16 * 32), kb = rr / 32, nb = rr % 32; const int rho = nb * 64;
        const int pn = rho >> 8, bj = (rho >> 7) & 1, j = rho & 127; const int c0 = bj * DFF + pn * 128 + j;
        transpose_item64(J.w_gu + (size_t)e * D_ * 2 * DFF, 2 * DFF, WGU + (size_t)e * 2 * DFF * D_, kb * 64, rho, c0, 64, lane); return; }
    r -= I_GU;
    { const int e = r / (16 * 16), rr = r % (16 * 16), kb = rr / 16, nb = rr % 16;
        transpose_item64(J.w_dn + (size_t)e * DFF * D_, D_, WDN + (size_t)e * D_ * DFF, kb * 64, nb * 64, nb * 64, 64, lane); }
}
struct ConvAddr { const float* src; size_t ld; bf16_t* dst; bool ok; };
__device__ __forceinline__ ConvAddr conv_addr(const Frame& F, const ConvJob& J, int it, int lane) {
    bf16_t* WIN = (bf16_t*)(F.ws + J.woff + WS_WIN); bf16_t* WOUT = (bf16_t*)(F.ws + J.woff + WS_WOUT); bf16_t* WGU = (bf16_t*)(F.ws + J.woff + WS_WGU); bf16_t* WDN = (bf16_t*)(F.ws + J.woff + WS_WDN);
    const int I_IN = 16 * (J.npad / 64), I_OUT = 16 * 16, I_GU = NE * 16 * 32;
    ConvAddr a; int r = it;
    if (r < I_IN) { const int nblk = J.npad / 64, kb = r / nblk, nb = r % nblk; const int c0 = nb * 64; int nv = J.nin - c0; nv = nv < 0 ? 0 : (nv > 64 ? 64 : nv);
        a.src = J.w_in + (size_t)(kb * 64) * J.nin + c0 + lane; a.ld = J.nin; a.dst = WIN + (size_t)(nb * 64 + lane) * 1024 + kb * 64; a.ok = lane < nv; return a; }
    r -= I_IN;
    if (r < I_OUT) { const int kb = r / 16, nb = r % 16; a.src = J.w_out + (size_t)(kb * 64) * D_ + nb * 64 + lane; a.ld = D_; a.dst = WOUT + (size_t)(nb * 64 + lane) * 1024 + kb * 64; a.ok = true; return a; }
    r -= I_OUT;
    if (r < I_GU) { const int e = r / (16 * 32), rr = r % (16 * 32), kb = rr / 32, nb = rr % 32; const int rho = nb * 64;
        const int pn = rho >> 8, bj = (rho >> 7) & 1, j = rho & 127; const int c0 = bj * DFF + pn * 128 + j;
        a.src = J.w_gu + (size_t)e * D_ * 2 * DFF + (size_t)(kb * 64) * (2 * DFF) + c0 + lane; a.ld = 2 * DFF; a.dst = WGU + (size_t)e * 2 * DFF * D_ + (size_t)(rho + lane) * 1024 + kb * 64; a.ok = true; return a; }
    r -= I_GU;
    { const int e = r / (16 * 16), rr = r % (16 * 16), kb = rr / 16, nb = rr % 16;
      a.src = J.w_dn + (size_t)e * DFF * D_ + (size_t)(kb * 64) * D_ + nb * 64 + lane; a.ld = D_; a.dst = WDN + (size_t)e * D_ * DFF + (size_t)(nb * 64 + lane) * 1024 + kb * 64; a.ok = true; return a; }
}
__device__ __forceinline__ void conv_load(const ConvAddr& a, float (&v)[64]) {
#pragma unroll
    for (int i = 0; i < 64; ++i) v[i] = a.ok ? a.src[(size_t)i * a.ld] : 0.f;
}
__device__ __forceinline__ void conv_store(const ConvAddr& a, const float (&v)[64]) {
    u32x4* dst = (u32x4*)a.dst;
#pragma unroll
    for (int j = 0; j < 8; ++j) { u32x4 o; o.x = pk2(v[8 * j], v[8 * j + 1]); o.y = pk2(v[8 * j + 2], v[8 * j + 3]); o.z = pk2(v[8 * j + 4], v[8 * j + 5]); o.w = pk2(v[8 * j + 6], v[8 * j + 7]); dst[j] = o; }
}
__device__ __forceinline__ void convert_weights(const Frame& F, const ConvJob& J, int nfirst) {
    for (int it = F.gw; it < nfirst; it += F.NGW) convert_item(F, J, it);
}
__device__ __forceinline__ void convert_queue(const Frame& F, const ConvJob& J, int* ctr, int max_batches, const int per_wave = 1, const int item0 = 0) {
    volatile LAS int* word = (volatile LAS int*)(F.lds + MISC_OFF + 64);
    const int n = conv_nitems(J);
    for (int b = 0; b < max_batches; ++b) {
        __syncthreads();
        if (F.tid == 0) *word = atomicAdd(ctr, NWAVES * per_wave);
        __syncthreads();
        const int base = *word;
        if (item0 + base >= n) break;
        for (int k = 0; k < per_wave; ++k) { const int it = item0 + base + k * NWAVES + F.wave; if (it < n) convert_item(F, J, it); }
    }
    __syncthreads();
}
__device__ __forceinline__ void convert_x(const Frame& F, const float* x, bf16_t* xb) {
    for (int m = F.gw; m < NTOK; m += F.NGW) {
        const f32x4* xr = (const f32x4*)(x + (size_t)m * D_) + F.lane; u32x2* o = (u32x2*)(xb + (size_t)m * D_) + F.lane;
#pragma unroll
        for (int j = 0; j < 4; ++j) { const f32x4 v = xr[64 * j]; u32x2 w; w.x = pk2(v[0], v[1]); w.y = pk2(v[2], v[3]); o[64 * j] = w; }
    }
}

__device__ __forceinline__ float key2f(unsigned k) { return __uint_as_float((k & 0x80000000u) ? (k ^ 0x80000000u) : ~k); }
__device__ __forceinline__ unsigned f2key(float f) { unsigned b = __float_as_uint(f); return b ^ ((b >> 31) ? 0xFFFFFFFFu : 0x80000000u); }

__device__ __forceinline__ void conv_phase(const Frame& F, const bf16_t* H, const float* cw, bf16_t* Y) {
    for (int idx = (F.vcu * NTHR + F.tid); idx < NTOK * 64; idx += F.G * NTHR) {
        const int tok = idx >> 6, c = (idx & 63) * 8, t = tok & (S_ - 1);
        const bf16_t* h = H + (size_t)tok * EVEN_PAD;
        float y[8] = {0.f, 0.f, 0.f, 0.f, 0.f, 0.f, 0.f, 0.f};
#pragma unroll
        for (int j = 0; j < 3; ++j) if (t >= j) { const bf16_t* hj = h - (size_t)j * EVEN_PAD; const u32x4 gc = *(const u32x4*)(hj + E_GC + c), xa = *(const u32x4*)(hj + E_XA + c);
            const f32x4 w0 = *(const f32x4*)(cw + j * 512 + c), w1 = *(const f32x4*)(cw + j * 512 + c + 4);
            y[0] += w0[0] * (bflo(gc.x) * bflo(xa.x)); y[1] += w0[1] * (bfhi(gc.x) * bfhi(xa.x)); y[2] += w0[2] * (bflo(gc.y) * bflo(xa.y)); y[3] += w0[3] * (bfhi(gc.y) * bfhi(xa.y));
            y[4] += w1[0] * (bflo(gc.z) * bflo(xa.z)); y[5] += w1[1] * (bfhi(gc.z) * bfhi(xa.z)); y[6] += w1[2] * (bflo(gc.w) * bflo(xa.w)); y[7] += w1[3] * (bfhi(gc.w) * bfhi(xa.w)); }
        const u32x4 gb = *(const u32x4*)(h + E_GB + c);
        u32x4 o; o.x = pk2(bflo(gb.x) * y[0], bfhi(gb.x) * y[1]); o.y = pk2(bflo(gb.y) * y[2], bfhi(gb.y) * y[3]); o.z = pk2(bflo(gb.z) * y[4], bfhi(gb.z) * y[5]); o.w = pk2(bflo(gb.w) * y[6], bfhi(gb.w) * y[7]);
        *(u32x4*)(Y + (size_t)tok * D_ + c) = o;
    }
}

__device__ __forceinline__ void dsa_select_phase(const Frame& F, const bf16_t* H, unsigned long long* MASK, const ConvJob& CJ, int* cctr, const int citem0) {
    typedef float f32x16 __attribute__((ext_vector_type(16)));
    LAS float* sc = (LAS float*)F.lds;
    const int lane = F.lane, wid = F.wave, c = lane & 31, hi = lane >> 5;
    const int rho = lane & 31, ah = (rho & 3) + 4 * ((rho >> 3) & 1), at = ((rho >> 2) & 1) + 2 * (rho >> 4);
    int cbase1 = -1;
    for (int itp = F.vcu; itp < 1024; itp += F.G) {
        const int bb = itp >> 8, vv = itp & 255;
        for (int pp = 0; pp < 2; ++pp) {
            const int p = pp ? 511 - vv : vv;
            const int tq0 = 8 * p, tmax = tq0 + 7, ntile = (tmax >> 5) + 1;
            if (F.tid == 0) *(volatile LAS int*)(F.lds + MISC_OFF + 64) = atomicAdd(cctr, 2 * NWAVES);
            const size_t row0 = (size_t)bb * S_ + tq0;
            bf16x8 af[2][2]; float wq[2][16];
#pragma unroll
            for (int g = 0; g < 2; ++g) {
                const bf16_t* qrow = H + (row0 + 4 * g + at) * EVEN_PAD + E_IQ + ah * 32 + 8 * hi;
                af[g][0] = *(const bf16x8*)qrow; af[g][1] = *(const bf16x8*)(qrow + 16);
#pragma unroll
                for (int q2 = 0; q2 < 2; ++q2) { const u32x4 w = *(const u32x4*)(H + (row0 + 4 * g + hi + 2 * q2) * EVEN_PAD + E_IW);
                    wq[g][8 * q2 + 0] = bflo(w.x); wq[g][8 * q2 + 1] = bfhi(w.x); wq[g][8 * q2 + 2] = bflo(w.y); wq[g][8 * q2 + 3] = bfhi(w.y);
                    wq[g][8 * q2 + 4] = bflo(w.z); wq[g][8 * q2 + 5] = bfhi(w.z); wq[g][8 * q2 + 6] = bflo(w.w); wq[g][8 * q2 + 7] = bfhi(w.w); }
            }
#define SEL_LOAD(BQ, tb_) do { _Pragma("unroll") for (int q4 = 0; q4 < 4; ++q4) { int tile = (tb_) + q4 * NWAVES; tile = tile < ntile ? tile : ntile - 1; \
                    const bf16_t* krow = H + ((size_t)bb * S_ + 32 * tile + c) * EVEN_PAD + E_IK + 8 * hi; \
                    BQ[q4][0] = *(const bf16x8*)krow; BQ[q4][1] = *(const bf16x8*)(krow + 16); } } while (0)
#define SEL_COMP(BQ, tb_) do { _Pragma("unroll") for (int q4 = 0; q4 < 4; ++q4) { const int tile = (tb_) + q4 * NWAVES; \
                    if (tile < ntile) { const int key = 32 * tile + c; \
                        _Pragma("unroll") for (int g = 0; g < 2; ++g) { \
                            f32x16 d = {0.f, 0.f, 0.f, 0.f, 0.f, 0.f, 0.f, 0.f, 0.f, 0.f, 0.f, 0.f, 0.f, 0.f, 0.f, 0.f}; \
                            d = __builtin_amdgcn_mfma_f32_32x32x16_bf16(af[g][0], BQ[q4][0], d, 0, 0, 0); \
                            d = __builtin_amdgcn_mfma_f32_32x32x16_bf16(af[g][1], BQ[q4][1], d, 0, 0, 0); \
                            float s0 = 0.f, s1 = 0.f; \
                            _Pragma("unroll") for (int r = 0; r < 8; ++r) { s0 += wq[g][r] * fmaxf(d[r], 0.f); s1 += wq[g][8 + r] * fmaxf(d[8 + r], 0.f); } \
                            sc[(4 * g + hi) * S_ + key] = s0; sc[(4 * g + hi + 2) * S_ + key] = s1; } } } } while (0)
            {
                const int cit1 = cbase1 >= 0 ? citem0 + cbase1 + NWAVES + wid : 0x7fffffff; const bool chas1 = cit1 < conv_nitems(CJ);
                ConvAddr ca1; float cv1[64];
                if (chas1) { ca1 = conv_addr(F, CJ, cit1, fresh_lane()); conv_load(ca1, cv1); }
                bf16x8 bqA[4][2];
                for (int tb = wid; tb < ntile; tb += 4 * NWAVES) { SEL_LOAD(bqA, tb); SEL_COMP(bqA, tb); }
                if (chas1) conv_store(ca1, cv1);
            }
#undef SEL_LOAD
#undef SEL_COMP
            __syncthreads();
            {
                const int lane2 = fresh_lane();
                const int t = tq0 + wid, n = t + 1;
                cbase1 = *(volatile LAS int*)(F.lds + MISC_OFF + 64);
                const int cit = citem0 + cbase1 + wid; const bool chas = cit < conv_nitems(CJ);
                ConvAddr ca; float cv[64];
                if (chas) { ca = conv_addr(F, CJ, cit, lane2); conv_load(ca, cv); }
                unsigned long long myword = 0ull;
                if (n <= 256) {
                    const int k0 = 64 * lane2;
                    myword = (k0 + 63 <= t) ? ~0ull : (k0 > t) ? 0ull : ((1ull << (t - k0 + 1)) - 1ull);
                } else {
                    const LAS float* scr = sc + wid * S_;
                    float u[64];
                    const int nreg = (n + 63) >> 6, nfull = n >> 6;
#pragma unroll
                    for (int ch = 0; ch < 4; ++ch) {
                        if (nfull >= 16 * ch + 16) {
#pragma unroll
                            for (int i = 16 * ch; i < 16 * ch + 16; ++i) u[i] = scr[64 * i + lane2];
                        } else if (nreg > 16 * ch) {
#pragma unroll
                            for (int i = 16 * ch; i < 16 * ch + 16; ++i) { const int s_ = 64 * i + lane2; const float v = scr[s_]; u[i] = (s_ <= t) ? v : -INFINITY; }
                        } else {
#pragma unroll
                            for (int i = 16 * ch; i < 16 * ch + 16; ++i) u[i] = -INFINITY;
                        }
                    }
                    unsigned T = 0u; bool exact = false;
#pragma unroll 1
                    for (int bit = 31; bit >= 0; --bit) {
                        const unsigned candk = T | (1u << bit); const float cand = key2f(candk); int c0_ = 0, c1_ = 0, c2_ = 0, c3_ = 0;
#define SEL_CNT4(i0) do { unsigned long long m0_, m1_, m2_, m3_; \
                            asm volatile("v_cmp_le_f32 %4, %12, %8\n\tv_cmp_le_f32 %5, %12, %9\n\tv_cmp_le_f32 %6, %12, %10\n\tv_cmp_le_f32 %7, %12, %11\n\t" \
                                         "v_addc_co_u32 %0, %4, 0, %0, %4\n\tv_addc_co_u32 %1, %5, 0, %1, %5\n\tv_addc_co_u32 %2, %6, 0, %2, %6\n\tv_addc_co_u32 %3, %7, 0, %3, %7" \
                                : "+v"(c0_), "+v"(c1_), "+v"(c2_), "+v"(c3_), "=&s"(m0_), "=&s"(m1_), "=&s"(m2_), "=&s"(m3_) \
                                : "v"(u[(i0)]), "v"(u[(i0) + 1]), "v"(u[(i0) + 2]), "v"(u[(i0) + 3]), "s"(cand)); } while (0)
#pragma unroll
                        for (int ch = 0; ch < 4; ++ch) if (nreg > 16 * ch) { SEL_CNT4(16 * ch); SEL_CNT4(16 * ch + 4); SEL_CNT4(16 * ch + 8); SEL_CNT4(16 * ch + 12); }
#undef SEL_CNT4
                        const int cl = wave_sum_iu((c0_ + c1_) + (c2_ + c3_));
                        if (cl >= 256) T = candk;
                        if (cl == 256) { exact = true; break; }
                    }
                    if (exact) {
                        float T3; { int tv = (int)T; asm volatile("" : "+v"(tv)); T3 = key2f((unsigned)__builtin_amdgcn_readfirstlane(tv)); }
#pragma unroll
                        for (int ch = 0; ch < 4; ++ch) if (nreg > 16 * ch) {
#pragma unroll
                            for (int i = 16 * ch; i < 16 * ch + 16; ++i) { const unsigned long long w = __ballot(u[i] >= T3); if (lane2 == i) myword = w; if ((i & 3) == 3) __builtin_amdgcn_sched_barrier(0); } }
                    } else {
                    int ngt = 0;
                    const float Tf = key2f(T);
#pragma unroll
                    for (int i = 0; i < 64; ++i) { ngt += __popcll(__ballot(u[i] > Tf)); if ((i & 3) == 3) __builtin_amdgcn_sched_barrier(0); }
                    int need = 256 - ngt;
                    float T2; { int tv = (int)T; asm volatile("" : "+v"(tv)); T2 = key2f((unsigned)__builtin_amdgcn_readfirstlane(tv)); }
                    int base = 0;
#pragma unroll
                    for (int i = 0; i < 64; ++i) {
                        const bool gtb = u[i] > T2, eqb = u[i] == T2;
                        const unsigned long long eq = __ballot(eqb);
                        const int rk = base + (int)__builtin_amdgcn_mbcnt_hi((unsigned)(eq >> 32), __builtin_amdgcn_mbcnt_lo((unsigned)eq, 0u));
                        const unsigned long long w = __ballot(gtb || (eqb && rk < need));
                        base += __popcll(eq);
                        if (lane2 == i) myword = w;
                        __builtin_amdgcn_sched_barrier(0);
                    }
                    }
                }
                MASK[(row0 + wid) * 64 + lane2] = myword;
                if (chas) conv_store(ca, cv);
            }
            __syncthreads();
        }
    }
    if (cbase1 >= 0) { const int citl = citem0 + cbase1 + NWAVES + wid; if (citl < conv_nitems(CJ)) convert_item(F, CJ, citl); }
}

namespace att {
typedef float f32x16 __attribute__((ext_vector_type(16)));
typedef short s16x4 __attribute__((ext_vector_type(4)));
constexpr int NW = 8, QBLK = 32, QB = 256, KVBLK = 64;
constexpr float C2 = 0.125f * 1.4426950408889634f;
constexpr float LOG2E = 1.4426950408889634f;
constexpr int SLOTB = 8192, LDS_K = 0, LDS_V = 3 * SLOTB, LDS_WS = 6 * SLOTB, LDS_OST = LDS_WS + NW * 256, LDS_ATT_BYTES = LDS_OST + NW * 4096;
constexpr int THR = 8;
#define SBAR() __builtin_amdgcn_sched_barrier(0)
#define PIN(x) asm volatile("" : "+v"(x))
#define MFMA(a, b, c) __builtin_amdgcn_mfma_f32_32x32x16_bf16(a, b, c, 0, 0, 0)
#define WAIT_BAR(N) asm volatile("s_waitcnt vmcnt(" #N ") lgkmcnt(0)\n\ts_barrier" ::: "memory")
__device__ __forceinline__ int crow(int r, int hi) { return (r & 3) + 8 * (r >> 2) + 4 * hi; }
__device__ __forceinline__ unsigned cvtpk(float lo, float hi) { unsigned r; asm("v_cvt_pk_bf16_f32 %0, %1, %2" : "=v"(r) : "v"(lo), "v"(hi)); return r; }
__device__ __forceinline__ void glds16(const void* g, unsigned lds_base) {
    unsigned sv; asm volatile("s_mov_b32 %0, m0\n\ts_mov_b32 m0, %2\n\ts_nop 0\n\tglobal_load_lds_dwordx4 %1, off\n\ts_mov_b32 m0, %0" : "=&s"(sv) : "v"(g), "s"(lds_base) : "memory"); }
typedef __attribute__((address_space(3))) const char* lds_cptr;
typedef short v4i16_t __attribute__((ext_vector_type(4)));
__device__ __forceinline__ void kload2(bf16x8* kf, lds_cptr kp, int d0) { kf[2 * d0] = *(const __attribute__((address_space(3))) bf16x8*)(kp + d0 * 2048); kf[2 * d0 + 1] = *(const __attribute__((address_space(3))) bf16x8*)(kp + d0 * 2048 + 512); }
__device__ __forceinline__ s16x4 vtr(lds_cptr p) { return __builtin_bit_cast(s16x4, __builtin_amdgcn_ds_read_tr16_b64_v4i16((__attribute__((address_space(3))) v4i16_t*)p)); }
#define MX3(a, b, c) __builtin_fmaxf(__builtin_fmaxf((a), (b)), (c))
__device__ __forceinline__ float max16(const f32x16& p) {
    float a = MX3(p[0], p[1], p[2]), b = MX3(p[3], p[4], p[5]); a = MX3(a, p[6], p[7]); b = MX3(b, p[8], p[9]); a = MX3(a, p[10], p[11]); b = MX3(b, p[12], p[13]); a = MX3(a, p[14], p[15]);
    return __builtin_fmaxf(a, b); }
__device__ __forceinline__ float halfmax(float m) { auto rr = __builtin_amdgcn_permlane32_swap(__float_as_uint(m), __float_as_uint(m), false, false); return __builtin_fmaxf(__uint_as_float(rr[0]), __uint_as_float(rr[1])); }
__device__ __forceinline__ void cmask(f32x16& p0, f32x16& p1, int jb, int qrel, int hi) {
    const int kb = 64 * jb + 4 * hi;
#pragma unroll
    for (int r = 0; r < 16; ++r) { const int kv = kb + (r & 3) + 8 * (r >> 2); if (kv > qrel) p0[r] = -INFINITY; if (kv + 32 > qrel) p1[r] = -INFINITY; } }
__device__ __forceinline__ void wmask(f32x16& p0, f32x16& p1, unsigned lo, unsigned hw, int hi) {
    lo >>= 4 * hi; hw >>= 4 * hi;
#pragma unroll
    for (int r = 0; r < 16; ++r) { const int cr = (r & 3) + 8 * (r >> 2);
        const unsigned m0 = (unsigned)((int)(lo << (31 - cr)) >> 31), m1 = (unsigned)((int)(hw << (31 - cr)) >> 31);
        p0[r] = __uint_as_float((__float_as_uint(p0[r]) & m0) | (0xff800000u & ~m0)); p1[r] = __uint_as_float((__float_as_uint(p1[r]) & m1) | (0xff800000u & ~m1)); } }

template <int MODE>
__device__ __forceinline__ void attn_unit(const bf16_t* Qh, const bf16_t* Kh, const bf16_t* Vh, bf16_t* Oh, const int QP, const int KP, const int VP, const int OP,
                                          const int rowbase, const int qb, const float sl2, const unsigned long long* maskp, char* lds, const int tid) {
    const int lane = tid & 63, r32 = lane & 31, hi = lane >> 5; const int wid = __builtin_amdgcn_readfirstlane(tid >> 6);
    const int q0 = qb * QB, NT = (q0 + QB) / KVBLK;
    const bf16_t* Qw = Qh + (size_t)(rowbase + q0 + wid * QBLK) * QP;
    const unsigned lds0 = (unsigned)(uintptr_t)lds; float* wsf = (float*)(lds + LDS_WS) + wid * 64;
    const bf16_t* ksrc = Kh + (size_t)rowbase * KP + (size_t)lane * KP + wid * 8;
    const bf16_t* vsrc = Vh + (size_t)rowbase * VP + (size_t)(16 * (wid & 3) + (lane >> 2)) * VP + (wid >> 2) * 32 + (lane & 3) * 8;
    const unsigned kdst = lds0 + LDS_K + wid * 1024, vdst = lds0 + LDS_V + wid * 1024;
#define DMA_K(t, slot) glds16(ksrc + (size_t)(NT - 1 - (t)) * KVBLK * KP, (unsigned)__builtin_amdgcn_readfirstlane(kdst + (slot)))
#define DMA_V(t, slot) glds16(vsrc + (size_t)(NT - 1 - (t)) * KVBLK * VP, (unsigned)__builtin_amdgcn_readfirstlane(vdst + (slot)))
    const lds_cptr vp0 = (lds_cptr)lds + LDS_V + ((lane >> 4) & 1) * 32 + (lane & 3) * 8 + (4 * hi + ((lane & 15) >> 2)) * 64;
    const lds_cptr kp0 = (lds_cptr)lds + LDS_K + hi * 1024 + r32 * 16;
    DMA_K(0, 0); DMA_V(0, 0); DMA_K(1, SLOTB);
    bf16x8 qr[4];
#pragma unroll
    for (int d0 = 0; d0 < 4; ++d0) qr[d0] = *reinterpret_cast<const bf16x8*>(&Qw[(size_t)r32 * QP + d0 * 16 + hi * 8]);
    const int qrel = wid * QBLK + r32;
    const unsigned moff = (unsigned)qrel * 512u;
    unsigned long long mw = 0ull;
    if (MODE == 1) mw = *(const unsigned long long*)((const char*)maskp + (moff + 8u * (unsigned)(NT - 1)));
    float mhat = 0.f, l_reg = 0.f; f32x16 o[2]; o[0] = f32x16{}; o[1] = f32x16{};
    f32x16 bz;
#pragma unroll
    for (int r = 0; r < 16; ++r) bz[r] = sl2 * (float)((r & 3) + 8 * (r >> 2) + 4 * hi - 255) * (1.0f / C2);
    PIN(bz);
    bool resc = false;
    f32x16 pA0, pA1, pB0, pB1; bf16x8 kf[8]; s16x4 vlo[8], vhi[8]; u32x4 pw0, pw1, pw2, pw3;
    int sl_prev = 0, sl_cur = 0, sl_next = SLOTB;
#define ROT() do { sl_prev = sl_cur; sl_cur = sl_next; sl_next = (sl_next == 2 * SLOTB) ? 0 : sl_next + SLOTB; } while (0)
#define EX0(v) __builtin_amdgcn_exp2f(__builtin_fmaf((v), C2, nmh0))
#define EX1(v) __builtin_amdgcn_exp2f(__builtin_fmaf((v), C2, nmh1))
#define BT0(t) (sl2 * (float)(64 * (3 - (t))))
#define RESC() do { if (resc) { _Pragma("unroll") for (int d_ = 0; d_ < 2; ++d_) _Pragma("unroll") for (int r = 0; r < 16; ++r) o[d_][r] *= wsf[crow(r, hi)]; } } while (0)
    DMA_K(2, 2 * SLOTB);
    WAIT_BAR(3);
    _Pragma("unroll") for (int d0 = 0; d0 < 4; ++d0) kload2(kf, kp0, d0);
    pA0 = MFMA(kf[0], qr[0], bz); pA1 = MFMA(kf[1], qr[0], bz); pA0 = MFMA(kf[2], qr[1], pA0); pA1 = MFMA(kf[3], qr[1], pA1);
    pA0 = MFMA(kf[4], qr[2], pA0); pA1 = MFMA(kf[5], qr[2], pA1); pA0 = MFMA(kf[6], qr[3], pA0); pA1 = MFMA(kf[7], qr[3], pA1);
    if (MODE == 0) cmask(pA0, pA1, 3, qrel, hi); else wmask(pA0, pA1, (unsigned)mw, (unsigned)(mw >> 32), hi);
    { const float b0 = BT0(0), b1 = b0 + 32.f * sl2;
      const float rm = halfmax(__builtin_fmaxf(__builtin_fmaf(max16(pA0), C2, b0), __builtin_fmaf(max16(pA1), C2, b1)));
      mhat = __builtin_fmaxf(rm, -1e30f); const float nmh0 = b0 - mhat, nmh1 = b1 - mhat;
#pragma unroll
      for (int r = 0; r < 16; ++r) { pA0[r] = EX0(pA0[r]); pA1[r] = EX1(pA1[r]); } }
    WAIT_BAR(0);
    DMA_K(3, 0); DMA_V(1, SLOTB); ROT();
    _Pragma("unroll") for (int d0 = 0; d0 < 4; ++d0) kload2(kf, kp0 + sl_cur, d0);
    WAIT_BAR(2);
#define PKW(P, i) cvtpk(P[i], P[i + 1])
#define PAF(k) __builtin_bit_cast(bf16x8, pw##k)
#define VFR(i) (bf16x8){vlo[i][0], vlo[i][1], vlo[i][2], vlo[i][3], vhi[i][0], vhi[i][1], vhi[i][2], vhi[i][3]}
#define VRD(i) do { vlo[i] = vtr(vp_ + (((i) >> 2) * 4096 + ((i) & 3) * 1024)); vhi[i] = vtr(vp_ + (((i) >> 2) * 4096 + ((i) & 3) * 1024 + 512)); } while (0)
#define KRD(G, d0) do { if (G) { kload2(kf, kp0 + sl_next, d0); SBAR(); } } while (0)
#define GAPA(MF, a0, a1, a2, a3, W0, W1, PW) do { MF; sacc += a0; sacc += a1; sacc += a2; sacc += a3; W0; W1; PIN(PW); PIN(sacc); SBAR(); } while (0)
#define GAPB0(MF, X, i) do { MF; X[i] = EX0(X[i]); X[i + 1] = EX0(X[i + 1]); X[i + 2] = EX0(X[i + 2]); X[i + 3] = EX0(X[i + 3]); PIN(X); SBAR(); } while (0)
#define GAPB1(MF, X, i) do { MF; X[i] = EX1(X[i]); X[i + 1] = EX1(X[i + 1]); X[i + 2] = EX1(X[i + 2]); X[i + 3] = EX1(X[i + 3]); PIN(X); SBAR(); } while (0)
#define STEP(C0, C1, P0, P1, t, MASK, GK, GV, GL) do { SBAR(); \
    const lds_cptr vp_ = vp0 + sl_prev; \
    if (MODE == 1) mw = *(const unsigned long long*)((const char*)maskp + (moff + 8u * (unsigned)(NT - 1 - (t)))); \
    VRD(0); SBAR(); float sacc = P0[0] + P0[1]; \
                    GAPA(C0 = MFMA(kf[0], qr[0], bz), P0[2], P0[3], P0[4], P0[5],     pw0[0] = PKW(P0, 0),  pw0[1] = PKW(P0, 2),  pw0); \
    VRD(4); SBAR(); GAPA(C1 = MFMA(kf[1], qr[0], bz), P0[6], P0[7], P0[8], P0[9],     pw0[2] = PKW(P0, 4),  pw0[3] = PKW(P0, 6),  pw0); \
    VRD(1); SBAR(); GAPA(C0 = MFMA(kf[2], qr[1], C0),    P0[10], P0[11], P0[12], P0[13], pw1[0] = PKW(P0, 8),  pw1[1] = PKW(P0, 10), pw1); \
    VRD(5); SBAR(); GAPA(C1 = MFMA(kf[3], qr[1], C1),    P0[14], P0[15], P1[0], P1[1],   pw1[2] = PKW(P0, 12), pw1[3] = PKW(P0, 14), pw1); \
    VRD(2); SBAR(); GAPA(C0 = MFMA(kf[4], qr[2], C0),    P1[2], P1[3], P1[4], P1[5],     pw2[0] = PKW(P1, 0),  pw2[1] = PKW(P1, 2),  pw2); \
    VRD(6); SBAR(); GAPA(C1 = MFMA(kf[5], qr[2], C1),    P1[6], P1[7], P1[8], P1[9],     pw2[2] = PKW(P1, 4),  pw2[3] = PKW(P1, 6),  pw2); \
    VRD(3); SBAR(); GAPA(C0 = MFMA(kf[6], qr[3], C0),    P1[10], P1[11], P1[12], P1[13], pw3[0] = PKW(P1, 8),  pw3[1] = PKW(P1, 10), pw3); \
    VRD(7); SBAR(); GAPA(C1 = MFMA(kf[7], qr[3], C1),    P1[14], P1[15], 0.f, 0.f,       pw3[2] = PKW(P1, 12), pw3[3] = PKW(P1, 14), pw3); \
    l_reg += sacc; \
    if (MODE == 1) wmask(C0, C1, (unsigned)mw, (unsigned)(mw >> 32), hi); \
    if (GK) DMA_K((t) + 3, sl_cur); if (GV) DMA_V((t) + 1, sl_next); \
    if (MODE == 0) { if (MASK) cmask(C0, C1, 3 - (t), qrel, hi); } \
    const float b0_ = BT0(t), b1_ = b0_ + 32.f * sl2; \
    { const float rma = halfmax(__builtin_fmaxf(__builtin_fmaf(max16(C0), C2, b0_), __builtin_fmaf(max16(C1), C2, b1_))); resc = false;     \
      if (__builtin_expect(__any(rma - mhat > (float)THR), 0)) { const float mn_ = __builtin_fmaxf(mhat, rma); \
          const float f = __builtin_amdgcn_exp2f(mhat - mn_); mhat = mn_; l_reg *= f; if (hi == 0) wsf[r32] = f; resc = true; } } \
    const float nmh0 = b0_ - mhat, nmh1 = b1_ - mhat; SBAR(); \
    GAPB0(o[0] = MFMA(PAF(0), VFR(0), o[0]), C0, 0);              GAPB0(o[1] = MFMA(PAF(0), VFR(4), o[1]), C0, 4); \
    KRD(GL, 0); GAPB0(o[0] = MFMA(PAF(1), VFR(1), o[0]), C0, 8);  KRD(GL, 1); GAPB0(o[1] = MFMA(PAF(1), VFR(5), o[1]), C0, 12); \
    KRD(GL, 2); GAPB1(o[0] = MFMA(PAF(2), VFR(2), o[0]), C1, 0);  KRD(GL, 3); GAPB1(o[1] = MFMA(PAF(2), VFR(6), o[1]), C1, 4); \
    GAPB1(o[0] = MFMA(PAF(3), VFR(3), o[0]), C1, 8);              GAPB1(o[1] = MFMA(PAF(3), VFR(7), o[1]), C1, 12); \
    } while (0)
#define ENDW(tt) do { if ((tt) + 3 < NT) { WAIT_BAR(2); } else if ((tt) + 2 < NT) { WAIT_BAR(1); } else { WAIT_BAR(0); } } while (0)
    int t = 1;
    for (; t <= 3 && t + 1 < NT; t += 2) {
        STEP(pB0, pB1, pA0, pA1, t, (t <= 3), (t + 3 < NT), (t + 1 < NT), (t + 1 < NT));             ENDW(t);     RESC(); ROT();
        STEP(pA0, pA1, pB0, pB1, t + 1, (t + 1 <= 3), (t + 4 < NT), (t + 2 < NT), (t + 2 < NT));     ENDW(t + 1); RESC(); ROT();
    }
    for (; t + 5 < NT; t += 2) {
        STEP(pB0, pB1, pA0, pA1, t, false, true, true, true);     WAIT_BAR(2); RESC(); ROT();
        STEP(pA0, pA1, pB0, pB1, t + 1, false, true, true, true); WAIT_BAR(2); RESC(); ROT();
    }
    for (; t + 1 < NT; t += 2) {
        STEP(pB0, pB1, pA0, pA1, t, (t <= 3), (t + 3 < NT), (t + 1 < NT), (t + 1 < NT));             ENDW(t);     RESC(); ROT();
        STEP(pA0, pA1, pB0, pB1, t + 1, (t + 1 <= 3), (t + 4 < NT), (t + 2 < NT), (t + 2 < NT));     ENDW(t + 1); RESC(); ROT();
    }
    STEP(pB0, pB1, pA0, pA1, NT - 1, (NT - 1 <= 3), false, false, false); RESC();
    { float sacc = pB0[0] + pB0[1];
#pragma unroll
      for (int r = 2; r < 16; ++r) sacc += pB0[r];
#pragma unroll
      for (int r = 0; r < 16; ++r) sacc += pB1[r];
      l_reg += sacc;
      pw0 = (u32x4){PKW(pB0, 0), PKW(pB0, 2), PKW(pB0, 4), PKW(pB0, 6)}; pw1 = (u32x4){PKW(pB0, 8), PKW(pB0, 10), PKW(pB0, 12), PKW(pB0, 14)};
      pw2 = (u32x4){PKW(pB1, 0), PKW(pB1, 2), PKW(pB1, 4), PKW(pB1, 6)}; pw3 = (u32x4){PKW(pB1, 8), PKW(pB1, 10), PKW(pB1, 12), PKW(pB1, 14)};
      const lds_cptr vp_ = vp0 + sl_cur; _Pragma("unroll") for (int i = 0; i < 8; ++i) VRD(i);
      o[0] = MFMA(PAF(0), VFR(0), o[0]); o[1] = MFMA(PAF(0), VFR(4), o[1]); o[0] = MFMA(PAF(1), VFR(1), o[0]); o[1] = MFMA(PAF(1), VFR(5), o[1]);
      o[0] = MFMA(PAF(2), VFR(2), o[0]); o[1] = MFMA(PAF(2), VFR(6), o[1]); o[0] = MFMA(PAF(3), VFR(3), o[0]); o[1] = MFMA(PAF(3), VFR(7), o[1]); }
    { auto rr = __builtin_amdgcn_permlane32_swap(__float_as_uint(l_reg), __float_as_uint(l_reg), false, false); l_reg = __uint_as_float(rr[0]) + __uint_as_float(rr[1]); }
    if (hi == 0) wsf[32 + r32] = l_reg; asm volatile("s_waitcnt lgkmcnt(0)" ::: "memory");
    float rli[16];
#pragma unroll
    for (int r = 0; r < 16; ++r) rli[r] = __builtin_amdgcn_rcpf(wsf[32 + crow(r, hi)]);
    bf16_t* Ow = Oh + (size_t)(rowbase + q0 + wid * QBLK) * OP; bf16_t* stg = (bf16_t*)(lds + LDS_OST) + wid * 2048;
#pragma unroll
    for (int r = 0; r < 16; ++r) { const int orow = crow(r, hi);
#pragma unroll
        for (int d0 = 0; d0 < 2; ++d0) stg[orow * 64 + d0 * 32 + r32] = (bf16_t)f2bf(o[d0][r] * rli[r]); }
    asm volatile("s_waitcnt lgkmcnt(0)" ::: "memory");
#pragma unroll
    for (int i = 0; i < 4; ++i) { const int row = i * 8 + (lane >> 3), ch = lane & 7; *(u32x4*)(Ow + (size_t)row * OP + ch * 8) = *(const u32x4*)(stg + row * 64 + ch * 8); }
    asm volatile("s_waitcnt lgkmcnt(0)\n\ts_barrier" ::: "memory");
#undef DMA_K
#undef DMA_V
#undef ROT
#undef EX0
#undef EX1
#undef BT0
#undef RESC
#undef PKW
#undef PAF
#undef VFR
#undef VRD
#undef KRD
#undef ENDW
#undef GAPA
#undef GAPB0
#undef GAPB1
#undef STEP
}
__device__ __forceinline__ void attn_unit_w(const bf16_t* Qh, const bf16_t* Kh, const bf16_t* Vh, bf16_t* Oh, const int QP, const int KP, const int VP, const int OP,
                                          const int rowbase, const int qb, const float sl2, const unsigned long long* maskp, char* lds, const int tid) {
    constexpr int MODE = 0; constexpr int L_WS = LDS_V + 6 * SLOTB;
    const int lane = tid & 63, r32 = lane & 31, hi = lane >> 5; const int wid = __builtin_amdgcn_readfirstlane(tid >> 6);
    const int q0 = qb * QB, NT = (q0 + QB) / KVBLK;
    const bf16_t* Qw = Qh + (size_t)(rowbase + q0 + wid * QBLK) * QP;
    const unsigned lds0 = (unsigned)(uintptr_t)lds; float* wsf = (float*)(lds + L_WS) + wid * 64;
    const bf16_t* ksrc = Kh + (size_t)rowbase * KP + (size_t)lane * KP + wid * 8;
    const bf16_t* vsrc = Vh + (size_t)rowbase * VP + (size_t)(16 * (wid & 3) + (lane >> 2)) * VP + (wid >> 2) * 32 + (lane & 3) * 8;
    const unsigned kdst = lds0 + LDS_K + wid * 1024, vdst = lds0 + LDS_V + wid * 1024;
#define DMA_K(t, slot) glds16(ksrc + (size_t)(NT - 1 - (t)) * KVBLK * KP, (unsigned)__builtin_amdgcn_readfirstlane(kdst + (slot)))
#define DMA_V(t, slot) do { glds16(vsrc + (size_t)(NT - 1 - (t)) * KVBLK * VP, (unsigned)__builtin_amdgcn_readfirstlane(vdst + 2 * (slot))); \
        glds16(vsrc + 64 + (size_t)(NT - 1 - (t)) * KVBLK * VP, (unsigned)__builtin_amdgcn_readfirstlane(vdst + 2 * (slot) + 8192)); } while (0)
    const lds_cptr vp0 = (lds_cptr)lds + LDS_V + ((lane >> 4) & 1) * 32 + (lane & 3) * 8 + (4 * hi + ((lane & 15) >> 2)) * 64;
    const lds_cptr kp0 = (lds_cptr)lds + LDS_K + hi * 1024 + r32 * 16;
    DMA_K(0, 0); DMA_V(0, 0); DMA_K(1, SLOTB);
    bf16x8 qr[4];
#pragma unroll
    for (int d0 = 0; d0 < 4; ++d0) qr[d0] = *reinterpret_cast<const bf16x8*>(&Qw[(size_t)r32 * QP + d0 * 16 + hi * 8]);
    const int qrel = wid * QBLK + r32;
    const unsigned moff = (unsigned)qrel * 512u;
    unsigned long long mw = 0ull;
    if (MODE == 1) mw = *(const unsigned long long*)((const char*)maskp + (moff + 8u * (unsigned)(NT - 1)));
    float mhat = 0.f, l_reg = 0.f; f32x16 o[4]; o[0] = f32x16{}; o[1] = f32x16{}; o[2] = f32x16{}; o[3] = f32x16{};
    f32x16 bz;
#pragma unroll
    for (int r = 0; r < 16; ++r) bz[r] = sl2 * (float)((r & 3) + 8 * (r >> 2) + 4 * hi - 255) * (1.0f / C2);
    PIN(bz);
    bool resc = false;
    f32x16 pA0, pA1, pB0, pB1; bf16x8 kf[8]; s16x4 vlo[8], vhi[8]; u32x4 pw0, pw1, pw2, pw3;
    int sl_prev = 0, sl_cur = 0, sl_next = SLOTB;
#define ROT() do { sl_prev = sl_cur; sl_cur = sl_next; sl_next = (sl_next == 2 * SLOTB) ? 0 : sl_next + SLOTB; } while (0)
#define EX0(v) __builtin_amdgcn_exp2f(__builtin_fmaf((v), C2, nmh0))
#define EX1(v) __builtin_amdgcn_exp2f(__builtin_fmaf((v), C2, nmh1))
#define BT0(t) (sl2 * (float)(64 * (3 - (t))))
#define RESC() do { if (resc) { _Pragma("unroll") for (int d_ = 0; d_ < 4; ++d_) _Pragma("unroll") for (int r = 0; r < 16; ++r) o[d_][r] *= wsf[crow(r, hi)]; } } while (0)
    DMA_K(2, 2 * SLOTB);
    WAIT_BAR(3);
    _Pragma("unroll") for (int d0 = 0; d0 < 4; ++d0) kload2(kf, kp0, d0);
    pA0 = MFMA(kf[0], qr[0], bz); pA1 = MFMA(kf[1], qr[0], bz); pA0 = MFMA(kf[2], qr[1], pA0); pA1 = MFMA(kf[3], qr[1], pA1);
    pA0 = MFMA(kf[4], qr[2], pA0); pA1 = MFMA(kf[5], qr[2], pA1); pA0 = MFMA(kf[6], qr[3], pA0); pA1 = MFMA(kf[7], qr[3], pA1);
    if (MODE == 0) cmask(pA0, pA1, 3, qrel, hi); else wmask(pA0, pA1, (unsigned)mw, (unsigned)(mw >> 32), hi);
    { const float b0 = BT0(0), b1 = b0 + 32.f * sl2;
      const float rm = halfmax(__builtin_fmaxf(__builtin_fmaf(max16(pA0), C2, b0), __builtin_fmaf(max16(pA1), C2, b1)));
      mhat = __builtin_fmaxf(rm, -1e30f); const float nmh0 = b0 - mhat, nmh1 = b1 - mhat;
#pragma unroll
      for (int r = 0; r < 16; ++r) { pA0[r] = EX0(pA0[r]); pA1[r] = EX1(pA1[r]); } }
    WAIT_BAR(0);
    DMA_K(3, 0); DMA_V(1, SLOTB); ROT();
    _Pragma("unroll") for (int d0 = 0; d0 < 4; ++d0) kload2(kf, kp0 + sl_cur, d0);
    WAIT_BAR(3);
#define PKW(P, i) cvtpk(P[i], P[i + 1])
#define PAF(k) __builtin_bit_cast(bf16x8, pw##k)
#define VFR(i) (bf16x8){vlo[i][0], vlo[i][1], vlo[i][2], vlo[i][3], vhi[i][0], vhi[i][1], vhi[i][2], vhi[i][3]}
#define VRD2(i) do { vlo[i] = vtr(vp_ + (8192 + ((i) >> 2) * 4096 + ((i) & 3) * 1024)); vhi[i] = vtr(vp_ + (8192 + ((i) >> 2) * 4096 + ((i) & 3) * 1024 + 512)); } while (0)
#define VRD(i) do { vlo[i] = vtr(vp_ + (((i) >> 2) * 4096 + ((i) & 3) * 1024)); vhi[i] = vtr(vp_ + (((i) >> 2) * 4096 + ((i) & 3) * 1024 + 512)); } while (0)
#define KRD(G, d0) do { if (G) { kload2(kf, kp0 + sl_next, d0); SBAR(); } } while (0)
#define GAPA(MF, a0, a1, a2, a3, W0, W1, PW) do { MF; sacc += a0; sacc += a1; sacc += a2; sacc += a3; W0; W1; PIN(PW); PIN(sacc); SBAR(); } while (0)
#define GAPH0(MF, X, i) do { MF; X[i] = EX0(X[i]); X[i + 1] = EX0(X[i + 1]); PIN(X); SBAR(); } while (0)
#define GAPH1(MF, X, i) do { MF; X[i] = EX1(X[i]); X[i + 1] = EX1(X[i + 1]); PIN(X); SBAR(); } while (0)
#define GAPB0(MF, X, i) do { MF; X[i] = EX0(X[i]); X[i + 1] = EX0(X[i + 1]); X[i + 2] = EX0(X[i + 2]); X[i + 3] = EX0(X[i + 3]); PIN(X); SBAR(); } while (0)
#define GAPB1(MF, X, i) do { MF; X[i] = EX1(X[i]); X[i + 1] = EX1(X[i + 1]); X[i + 2] = EX1(X[i + 2]); X[i + 3] = EX1(X[i + 3]); PIN(X); SBAR(); } while (0)
#define STEP(C0, C1, P0, P1, t, MASK, GK, GV, GL) do { SBAR(); \
    const lds_cptr vp_ = vp0 + 2 * sl_prev; \
    if (MODE == 1) mw = *(const unsigned long long*)((const char*)maskp + (moff + 8u * (unsigned)(NT - 1 - (t)))); \
    VRD(0); SBAR(); float sacc = P0[0] + P0[1]; \
                    GAPA(C0 = MFMA(kf[0], qr[0], bz), P0[2], P0[3], P0[4], P0[5],     pw0[0] = PKW(P0, 0),  pw0[1] = PKW(P0, 2),  pw0); \
    VRD(4); SBAR(); GAPA(C1 = MFMA(kf[1], qr[0], bz), P0[6], P0[7], P0[8], P0[9],     pw0[2] = PKW(P0, 4),  pw0[3] = PKW(P0, 6),  pw0); \
    VRD(1); SBAR(); GAPA(C0 = MFMA(kf[2], qr[1], C0),    P0[10], P0[11], P0[12], P0[13], pw1[0] = PKW(P0, 8),  pw1[1] = PKW(P0, 10), pw1); \
    VRD(5); SBAR(); GAPA(C1 = MFMA(kf[3], qr[1], C1),    P0[14], P0[15], P1[0], P1[1],   pw1[2] = PKW(P0, 12), pw1[3] = PKW(P0, 14), pw1); \
    VRD(2); SBAR(); GAPA(C0 = MFMA(kf[4], qr[2], C0),    P1[2], P1[3], P1[4], P1[5],     pw2[0] = PKW(P1, 0),  pw2[1] = PKW(P1, 2),  pw2); \
    VRD(6); SBAR(); GAPA(C1 = MFMA(kf[5], qr[2], C1),    P1[6], P1[7], P1[8], P1[9],     pw2[2] = PKW(P1, 4),  pw2[3] = PKW(P1, 6),  pw2); \
    VRD(3); SBAR(); GAPA(C0 = MFMA(kf[6], qr[3], C0),    P1[10], P1[11], P1[12], P1[13], pw3[0] = PKW(P1, 8),  pw3[1] = PKW(P1, 10), pw3); \
    VRD(7); SBAR(); GAPA(C1 = MFMA(kf[7], qr[3], C1),    P1[14], P1[15], 0.f, 0.f,       pw3[2] = PKW(P1, 12), pw3[3] = PKW(P1, 14), pw3); \
    l_reg += sacc; \
    if (MODE == 1) wmask(C0, C1, (unsigned)mw, (unsigned)(mw >> 32), hi); \
    if (GK) DMA_K((t) + 3, sl_cur); if (GV) DMA_V((t) + 1, sl_next); \
    if (MODE == 0) { if (MASK) cmask(C0, C1, 3 - (t), qrel, hi); } \
    const float b0_ = BT0(t), b1_ = b0_ + 32.f * sl2; \
    { const float rma = halfmax(__builtin_fmaxf(__builtin_fmaf(max16(C0), C2, b0_), __builtin_fmaf(max16(C1), C2, b1_))); resc = false;     \
      if (__builtin_expect(__any(rma - mhat > (float)THR), 0)) { const float mn_ = __builtin_fmaxf(mhat, rma); \
          const float f = __builtin_amdgcn_exp2f(mhat - mn_); mhat = mn_; l_reg *= f; if (hi == 0) wsf[r32] = f; resc = true; } } \
    const float nmh0 = b0_ - mhat, nmh1 = b1_ - mhat; SBAR(); \
    GAPH0(o[0] = MFMA(PAF(0), VFR(0), o[0]), C0, 0);  VRD2(0); SBAR(); GAPH0(o[1] = MFMA(PAF(0), VFR(4), o[1]), C0, 2);  VRD2(4); SBAR(); \
    GAPH0(o[0] = MFMA(PAF(1), VFR(1), o[0]), C0, 4);  VRD2(1); SBAR(); GAPH0(o[1] = MFMA(PAF(1), VFR(5), o[1]), C0, 6);  VRD2(5); SBAR(); \
    GAPH0(o[0] = MFMA(PAF(2), VFR(2), o[0]), C0, 8);  VRD2(2); SBAR(); GAPH0(o[1] = MFMA(PAF(2), VFR(6), o[1]), C0, 10); VRD2(6); SBAR(); \
    GAPH0(o[0] = MFMA(PAF(3), VFR(3), o[0]), C0, 12); VRD2(3); SBAR(); GAPH0(o[1] = MFMA(PAF(3), VFR(7), o[1]), C0, 14); VRD2(7); SBAR(); \
    KRD(GL, 0); GAPH1(o[2] = MFMA(PAF(0), VFR(0), o[2]), C1, 0);  KRD(GL, 1); GAPH1(o[3] = MFMA(PAF(0), VFR(4), o[3]), C1, 2); \
    KRD(GL, 2); GAPH1(o[2] = MFMA(PAF(1), VFR(1), o[2]), C1, 4);  KRD(GL, 3); GAPH1(o[3] = MFMA(PAF(1), VFR(5), o[3]), C1, 6); \
    GAPH1(o[2] = MFMA(PAF(2), VFR(2), o[2]), C1, 8);              GAPH1(o[3] = MFMA(PAF(2), VFR(6), o[3]), C1, 10); \
    GAPH1(o[2] = MFMA(PAF(3), VFR(3), o[2]), C1, 12);             GAPH1(o[3] = MFMA(PAF(3), VFR(7), o[3]), C1, 14); \
    } while (0)
#define ENDW(tt) do { if ((tt) + 3 < NT) { WAIT_BAR(3); } else if ((tt) + 2 < NT) { WAIT_BAR(2); } else { WAIT_BAR(0); } } while (0)
    int t = 1;
    for (; t <= 3 && t + 1 < NT; t += 2) {
        STEP(pB0, pB1, pA0, pA1, t, (t <= 3), (t + 3 < NT), (t + 1 < NT), (t + 1 < NT));             ENDW(t);     RESC(); ROT();
        STEP(pA0, pA1, pB0, pB1, t + 1, (t + 1 <= 3), (t + 4 < NT), (t + 2 < NT), (t + 2 < NT));     ENDW(t + 1); RESC(); ROT();
    }
    for (; t + 5 < NT; t += 2) {
        STEP(pB0, pB1, pA0, pA1, t, false, true, true, true);     WAIT_BAR(3); RESC(); ROT();
        STEP(pA0, pA1, pB0, pB1, t + 1, false, true, true, true); WAIT_BAR(3); RESC(); ROT();
    }
    for (; t + 1 < NT; t += 2) {
        STEP(pB0, pB1, pA0, pA1, t, (t <= 3), (t + 3 < NT), (t + 1 < NT), (t + 1 < NT));             ENDW(t);     RESC(); ROT();
        STEP(pA0, pA1, pB0, pB1, t + 1, (t + 1 <= 3), (t + 4 < NT), (t + 2 < NT), (t + 2 < NT));     ENDW(t + 1); RESC(); ROT();
    }
    STEP(pB0, pB1, pA0, pA1, NT - 1, (NT - 1 <= 3), false, false, false); RESC();
    { float sacc = pB0[0] + pB0[1];
#pragma unroll
      for (int r = 2; r < 16; ++r) sacc += pB0[r];
#pragma unroll
      for (int r = 0; r < 16; ++r) sacc += pB1[r];
      l_reg += sacc;
      pw0 = (u32x4){PKW(pB0, 0), PKW(pB0, 2), PKW(pB0, 4), PKW(pB0, 6)}; pw1 = (u32x4){PKW(pB0, 8), PKW(pB0, 10), PKW(pB0, 12), PKW(pB0, 14)};
      pw2 = (u32x4){PKW(pB1, 0), PKW(pB1, 2), PKW(pB1, 4), PKW(pB1, 6)}; pw3 = (u32x4){PKW(pB1, 8), PKW(pB1, 10), PKW(pB1, 12), PKW(pB1, 14)};
      const lds_cptr vp_ = vp0 + 2 * sl_cur; _Pragma("unroll") for (int i = 0; i < 8; ++i) VRD(i);
      o[0] = MFMA(PAF(0), VFR(0), o[0]); o[1] = MFMA(PAF(0), VFR(4), o[1]); o[0] = MFMA(PAF(1), VFR(1), o[0]); o[1] = MFMA(PAF(1), VFR(5), o[1]);
      o[0] = MFMA(PAF(2), VFR(2), o[0]); o[1] = MFMA(PAF(2), VFR(6), o[1]); o[0] = MFMA(PAF(3), VFR(3), o[0]); o[1] = MFMA(PAF(3), VFR(7), o[1]);
      SBAR(); _Pragma("unroll") for (int i = 0; i < 8; ++i) VRD2(i);
      o[2] = MFMA(PAF(0), VFR(0), o[2]); o[3] = MFMA(PAF(0), VFR(4), o[3]); o[2] = MFMA(PAF(1), VFR(1), o[2]); o[3] = MFMA(PAF(1), VFR(5), o[3]);
      o[2] = MFMA(PAF(2), VFR(2), o[2]); o[3] = MFMA(PAF(2), VFR(6), o[3]); o[2] = MFMA(PAF(3), VFR(3), o[2]); o[3] = MFMA(PAF(3), VFR(7), o[3]); }
    { auto rr = __builtin_amdgcn_permlane32_swap(__float_as_uint(l_reg), __float_as_uint(l_reg), false, false); l_reg = __uint_as_float(rr[0]) + __uint_as_float(rr[1]); }
    if (hi == 0) wsf[32 + r32] = l_reg; asm volatile("s_waitcnt lgkmcnt(0)" ::: "memory");
    float rli[16];
#pragma unroll
    for (int r = 0; r < 16; ++r) rli[r] = __builtin_amdgcn_rcpf(wsf[32 + crow(r, hi)]);
    bf16_t* Ow = Oh + (size_t)(rowbase + q0 + wid * QBLK) * OP; bf16_t* stg = (bf16_t*)lds + wid * 4096;
    asm volatile("s_waitcnt lgkmcnt(0)\n\ts_barrier" ::: "memory");
#pragma unroll
    for (int r = 0; r < 16; ++r) { const int orow = crow(r, hi);
#pragma unroll
        for (int d0 = 0; d0 < 4; ++d0) stg[orow * 128 + d0 * 32 + r32] = (bf16_t)f2bf(o[d0][r] * rli[r]); }
    asm volatile("s_waitcnt lgkmcnt(0)" ::: "memory");
#pragma unroll
    for (int i = 0; i < 8; ++i) { const int row = i * 4 + (lane >> 4), ch = lane & 15; *(u32x4*)(Ow + (size_t)row * OP + ch * 8) = *(const u32x4*)(stg + row * 128 + ch * 8); }
    asm volatile("s_waitcnt lgkmcnt(0)\n\ts_barrier" ::: "memory");
#undef DMA_K
#undef DMA_V
#undef ROT
#undef EX0
#undef EX1
#undef BT0
#undef RESC
#undef PKW
#undef PAF
#undef VFR
#undef VRD
#undef VRD2
#undef GAPH0
#undef GAPH1
#undef KRD
#undef ENDW
#undef GAPA
#undef GAPB0
#undef GAPB1
#undef STEP
}
#undef SBAR
#undef PIN
#undef MFMA
#undef WAIT_BAR
#undef MX3
}

__device__ __forceinline__ void diff_attn_phase(const Frame& F, const bf16_t* H, bf16_t* OD) {
    for (int u = F.vcu; u < 512; u += F.G) {
        const int v = u & 255, i = u >> 8, bhc = v >> 3, s = v & 7;
        const int qb = (i == 0) ? 15 - s : s;
        const int b = bhc >> 3, h = (bhc >> 1) & 3, c = bhc & 1;
        const float sl2 = exp2f(-2.0f * (float)(h + 1)) * att::LOG2E;
        const int tidl = F.wave * 64 + fresh_lane();
        att::attn_unit_w(H + O_QC + h * 128 + c * 64, H + O_KC + h * 128 + c * 64, H + O_VC + h * 128, OD + h * 256 + c * 128,
                         ODD_IN, ODD_IN, ODD_IN, D_, b * S_, qb, sl2, nullptr, (char*)F.lds, tidl);
    }
}
__device__ __forceinline__ void dsa_attn_phase(const Frame& F, const bf16_t* H, const unsigned long long* MASK, bf16_t* Y) {
    for (int u = F.vcu; u < 512; u += F.G) {
        const int v = u & 255, i = u >> 8, pair = v >> 3, s = v & 7;
        const int qb = (i == 0) ? s : 15 - s;
        const int b = pair >> 3, h = pair & 7;
        const float sl2 = exp2f(-(float)(h + 1)) * att::LOG2E;
        const int tidl = F.wave * 64 + fresh_lane();
        att::attn_unit<1>(H + E_Q + h * 64, H + E_K + h * 64, H + E_V + h * 64, Y + 512 + h * 64, EVEN_PAD, EVEN_PAD, EVEN_PAD, D_, b * S_, qb, sl2,
                          MASK + ((size_t)b * S_ + qb * 256) * 64, (char*)F.lds, tidl);
    }
}
__device__ __forceinline__ void diff_combine_phase(const Frame& F, const bf16_t* OD, const float* lq1, const float* lk1, const float* lq2, const float* lk2, const float* subg, bf16_t* Y) {
    const int lane = F.lane;
    const float lam_init = 0.8f - 0.6f * expf(-0.3f);
    const float s1 = wave_sum(lq1[lane] * lk1[lane]), s2 = wave_sum(lq2[lane] * lk2[lane]);
    const float lam = expf(s1) - expf(s2) + lam_init;
    const int h = lane >> 4, e0 = (lane & 15) * 8;
    float gsc[8];
#pragma unroll
    for (int j = 0; j < 8; ++j) gsc[j] = subg[e0 + j] * (1.0f - lam_init);
    for (int tok = F.gw; tok < NTOK; tok += F.NGW) {
        const u32x4 a = *(const u32x4*)(OD + (size_t)tok * D_ + h * 256 + e0), bq = *(const u32x4*)(OD + (size_t)tok * D_ + h * 256 + 128 + e0);
        float r[8];
        r[0] = bflo(a.x) - lam * bflo(bq.x); r[1] = bfhi(a.x) - lam * bfhi(bq.x); r[2] = bflo(a.y) - lam * bflo(bq.y); r[3] = bfhi(a.y) - lam * bfhi(bq.y);
        r[4] = bflo(a.z) - lam * bflo(bq.z); r[5] = bfhi(a.z) - lam * bfhi(bq.z); r[6] = bflo(a.w) - lam * bflo(bq.w); r[7] = bfhi(a.w) - lam * bfhi(bq.w);
        float ss = 0.f;
#pragma unroll
        for (int j = 0; j < 8; ++j) ss += r[j] * r[j];
        ss += __shfl_xor(ss, 1); ss += __shfl_xor(ss, 2); ss += __shfl_xor(ss, 4); ss += __shfl_xor(ss, 8);
        const float rs = rsqrtf(ss * (1.0f / 128.0f) + RMS_EPS);
        u32x4 w; w.x = pk2(r[0] * rs * gsc[0], r[1] * rs * gsc[1]); w.y = pk2(r[2] * rs * gsc[2], r[3] * rs * gsc[3]); w.z = pk2(r[4] * rs * gsc[4], r[5] * rs * gsc[5]); w.w = pk2(r[6] * rs * gsc[6], r[7] * rs * gsc[7]);
        *(u32x4*)(Y + (size_t)tok * D_ + h * 128 + e0) = w;
    }
}


namespace dil {
typedef float f32x16 __attribute__((ext_vector_type(16)));
typedef short s16x4 __attribute__((ext_vector_type(4)));
constexpr float C2 = 0.125f * 1.4426950408889634f, LOG2E = 1.4426950408889634f;
#define DMFMA(a, b, c) __builtin_amdgcn_mfma_f32_32x32x16_bf16(a, b, c, 0, 0, 0)
template <int PH> __device__ __forceinline__ void tile_desc(int j, int& g, int& tile) {
    if (PH == 0) { g = 0; tile = 4 - j; } else { g = j < 8 ? 1 : 2; tile = j < 8 ? 7 - j : 12 - j; } }
__device__ __forceinline__ int clamp_s(int sk) { return sk < 0 ? 0 : (sk > S_ - 1 ? S_ - 1 : sk); }
template <int PH> __device__ __forceinline__ void dil_task(const Frame& F, const bf16_t* H, bf16_t* Y, float* PB, float2* PM, int b, int h, int blk, int sub) {
        constexpr int NT = PH == 0 ? 5 : 13, QS = PH == 0 ? 1 : 16;
        const int lane = fresh_lane();
        const int r32 = lane & 31, hi = lane >> 5;
        char* ldsw = (char*)F.lds + F.wave * 16384;
        const unsigned ldsv = (unsigned)(uintptr_t)ldsw;
        const att::lds_cptr vp0 = (att::lds_cptr)ldsw + 8192 + ((lane >> 4) & 1) * 32 + (lane & 3) * 8 + (4 * hi + ((lane & 15) >> 2)) * 64;
        const att::lds_cptr kp0 = (att::lds_cptr)ldsw + r32 * 128;
        const int u0 = blk * 512 + (PH == 0 ? 32 * sub : sub); const size_t rb = (size_t)b * S_;
        const float sl2 = exp2f(-(float)(h + 1)) * LOG2E;
        const bf16_t* Qp = H + (rb + u0 + QS * r32) * ODD_IN + O_QD + h * 64 + 8 * hi;
        const bf16_t* Kb = H + rb * ODD_IN + O_KD + h * 64 + ((lane & 7) ^ (lane >> 3)) * 8;
        const bf16_t* Vb = H + rb * ODD_IN + O_VD + h * 64 + (lane & 3) * 8;
        asm volatile("s_waitcnt vmcnt(0)" ::: "memory");
#define DIL_ISSUE(j_) do { int g_, tl_; tile_desc<PH>((j_), g_, tl_); const int st_ = 1 << (2 * g_), s0_ = u0 - (128 << (2 * g_)) + (st_ << 5) * tl_; \
            const unsigned kdst_ = (unsigned)__builtin_amdgcn_readfirstlane(ldsv + ((j_) & 1) * 4096), vdst_ = kdst_ + 8192u; \
            if (s0_ >= 0 && s0_ + 31 * st_ < S_) {              \
                const bf16_t* kp_ = Kb + (size_t)(s0_ + st_ * (lane >> 3)) * ODD_IN; const bf16_t* vp_ = Vb + (size_t)(s0_ + st_ * (lane >> 2)) * ODD_IN; const size_t ks_ = (size_t)(8 * st_) * ODD_IN; \
                _Pragma("unroll") for (int c = 0; c < 4; ++c) att::glds16(kp_ + c * ks_, kdst_ + c * 1024); \
                _Pragma("unroll") for (int c = 0; c < 4; ++c) att::glds16(vp_ + (c & 1) * 2 * ks_ + (c >> 1) * 32, vdst_ + c * 1024); \
            } else { \
                _Pragma("unroll") for (int c = 0; c < 4; ++c) { const int sk = clamp_s(s0_ + st_ * (8 * c + (lane >> 3))); att::glds16(Kb + (size_t)sk * ODD_IN, kdst_ + c * 1024); } \
                _Pragma("unroll") for (int c = 0; c < 4; ++c) { const int sk = clamp_s(s0_ + st_ * (16 * (c & 1) + (lane >> 2))); att::glds16(Vb + (size_t)sk * ODD_IN + (c >> 1) * 32, vdst_ + c * 1024); } } } while (0)
        DIL_ISSUE(0);
        bf16x8 qr[4];
#pragma unroll
        for (int d0 = 0; d0 < 4; ++d0) qr[d0] = *(const bf16x8*)(Qp + 16 * d0);
        float mhat = -1e30f, l_reg = 0.f; f32x16 o[2]; o[0] = f32x16{}; o[1] = f32x16{};
        if (PH == 1) {
            const float2 ml = PM[sub + 16 * r32]; mhat = ml.x; l_reg = hi ? 0.f : ml.y;
            const float* PBp = PB + (size_t)sub * 64 + r32;
#pragma unroll
            for (int r = 0; r < 16; ++r) { const int row = att::crow(r, hi); o[0][r] = PBp[(size_t)(16 * row) * 64]; o[1][r] = PBp[(size_t)(16 * row) * 64 + 32]; }
        }
        asm volatile("" : "+v"(o[0]), "+v"(o[1]), "+v"(mhat), "+v"(l_reg), "+v"(qr[0]), "+v"(qr[1]), "+v"(qr[2]), "+v"(qr[3]));
        int gprev = -1; f32x16 bz = f32x16{};
#pragma unroll 1
        for (int j = 0; j < NT; ++j) {
            int g, tile; tile_desc<PH>(j, g, tile);
            const int ST = 1 << (2 * g), W = 128 << (2 * g);
            if (g != gprev) { gprev = g;
#pragma unroll
                for (int r = 0; r < 16; ++r) bz[r] = sl2 * (float)(ST * ((r & 3) + 8 * (r >> 2) + 4 * hi)) * (1.0f / C2); }
            const int s0t = u0 - W + ST * 32 * tile;
            if (j + 1 < NT) { DIL_ISSUE(j + 1); asm volatile("s_waitcnt vmcnt(8)" ::: "memory"); } else asm volatile("s_waitcnt vmcnt(0)" ::: "memory");
            bf16x8 kf[4];
            { const att::lds_cptr kpj = kp0 + (j & 1) * 4096;
#pragma unroll
              for (int d0 = 0; d0 < 4; ++d0) kf[d0] = *(const __attribute__((address_space(3))) bf16x8*)(kpj + (((2 * d0 + hi) ^ (r32 & 7)) * 16)); }
            f32x16 C0 = DMFMA(kf[0], qr[0], bz);
            C0 = DMFMA(kf[1], qr[1], C0); C0 = DMFMA(kf[2], qr[2], C0); C0 = DMFMA(kf[3], qr[3], C0);
            __builtin_amdgcn_sched_barrier(0);
            const int dq = QS * r32 + W - ST * 32 * tile - ST * 4 * hi;
            int kmin = 0; if (s0t < 0) kmin = (-s0t + ST - 1) >> (2 * g);
            const int km0 = kmin - 4 * hi;
            unsigned vmask;
            { const int hx = dq >> (2 * g); int lx = (dq - W + ST - 1) >> (2 * g); lx = lx > km0 ? lx : km0; lx = lx > 0 ? lx : 0;
              const unsigned up = hx >= 31 ? 0xFFFFFFFFu : ((2u << (hx & 31)) - 1u), dn = lx > 31 ? 0xFFFFFFFFu : ((1u << (lx & 31)) - 1u);
              vmask = (hx < 0 || lx > hx) ? 0u : (up & ~dn); }
#pragma unroll
            for (int r = 0; r < 16; ++r) { const int cr = (r & 3) + 8 * (r >> 2); const unsigned t_ = (unsigned)((int)(vmask << (31 - cr)) >> 31);
                C0[r] = __uint_as_float((__float_as_uint(C0[r]) & t_) | (0xff800000u & ~t_)); }
            const float nb0 = -sl2 * (float)(QS * r32 + W - ST * 32 * tile);
            const float rma = att::halfmax(__builtin_fmaf(att::max16(C0), C2, nb0));
            if (__any(rma - mhat > 6.0f)) {
                const float mn_ = __builtin_fmaxf(mhat, rma); const float f = __builtin_amdgcn_exp2f(mhat - mn_); mhat = mn_; l_reg *= f;
#pragma unroll
                for (int r = 0; r < 16; ++r) {
                    const float f0 = __builtin_bit_cast(float, __builtin_amdgcn_readlane(__builtin_bit_cast(int, f), (r & 3) + 8 * (r >> 2)));
                    const float f1 = __builtin_bit_cast(float, __builtin_amdgcn_readlane(__builtin_bit_cast(int, f), (r & 3) + 8 * (r >> 2) + 4));
                    const float fr = hi ? f1 : f0; o[0][r] *= fr; o[1][r] *= fr; }
            }
            const float nmh0 = nb0 - mhat;
            float sacc = 0.f;
#pragma unroll
            for (int r = 0; r < 16; ++r) { C0[r] = __builtin_amdgcn_exp2f(__builtin_fmaf(C0[r], C2, nmh0)); sacc += C0[r]; }
            l_reg += sacc;
            u32x4 pw0, pw1;
            pw0 = (u32x4){att::cvtpk(C0[0], C0[1]), att::cvtpk(C0[2], C0[3]), att::cvtpk(C0[4], C0[5]), att::cvtpk(C0[6], C0[7])};
            pw1 = (u32x4){att::cvtpk(C0[8], C0[9]), att::cvtpk(C0[10], C0[11]), att::cvtpk(C0[12], C0[13]), att::cvtpk(C0[14], C0[15])};
            asm volatile("s_nop 1" : "+v"(pw0), "+v"(pw1));
            {
                const att::lds_cptr vpj = vp0 + (j & 1) * 4096;
                s16x4 vlo[4], vhi[4];
#define DVFR(i) (bf16x8){vlo[i][0], vlo[i][1], vlo[i][2], vlo[i][3], vhi[i][0], vhi[i][1], vhi[i][2], vhi[i][3]}
#pragma unroll
                for (int i = 0; i < 4; ++i) { vlo[i] = att::vtr(vpj + ((i >> 1) * 2048 + (i & 1) * 1024)); vhi[i] = att::vtr(vpj + ((i >> 1) * 2048 + (i & 1) * 1024 + 512)); }
                o[0] = DMFMA(__builtin_bit_cast(bf16x8, pw0), DVFR(0), o[0]); o[1] = DMFMA(__builtin_bit_cast(bf16x8, pw0), DVFR(2), o[1]);
                o[0] = DMFMA(__builtin_bit_cast(bf16x8, pw1), DVFR(1), o[0]); o[1] = DMFMA(__builtin_bit_cast(bf16x8, pw1), DVFR(3), o[1]);
                __builtin_amdgcn_sched_barrier(0);
#undef DVFR
            }
            asm volatile("s_waitcnt lgkmcnt(0)" ::: "memory");
        }
#undef DIL_ISSUE
        { auto rr = __builtin_amdgcn_permlane32_swap(__float_as_uint(l_reg), __float_as_uint(l_reg), false, false); l_reg = __uint_as_float(rr[0]) + __uint_as_float(rr[1]); }
        const int lane3 = fresh_lane();
        const int hi3 = lane3 >> 5;
        if (PH == 0) {
            float* PBp = PB + (size_t)(32 * sub) * 64 + (lane3 & 31);
#pragma unroll
            for (int r = 0; r < 16; ++r) { const int row = att::crow(r, hi3); PBp[row * 64] = o[0][r]; PBp[row * 64 + 32] = o[1][r]; }
            if (hi3 == 0) PM[32 * sub + lane3] = make_float2(mhat, l_reg);
        } else {
            const float rl = __builtin_amdgcn_rcpf(l_reg);
            bf16_t* Yp = Y + (rb + u0) * D_ + 512 + h * 64 + (lane3 & 31);
#pragma unroll
            for (int r = 0; r < 16; ++r) { const int row = att::crow(r, hi3); const float rli = __shfl(rl, row);
                Yp[(size_t)(16 * row) * D_] = (bf16_t)f2bf(o[0][r] * rli); Yp[(size_t)(16 * row) * D_ + 32] = (bf16_t)f2bf(o[1][r] * rli); }
        }
}
__device__ __forceinline__ void dil_phase(const Frame& F, const bf16_t* H, bf16_t* Y, float* PBALL) {
    for (int unit = F.vcu; unit < 256; unit += F.G) {
        const int h = unit & 7, blk = (unit >> 3) & 7, b = unit >> 6;
        float* PB = PBALL + (size_t)unit * (512 * 64 + 1024); float2* PM = (float2*)(PB + 512 * 64);
        dil_task<0>(F, H, Y, PB, PM, b, h, blk, F.wave); dil_task<0>(F, H, Y, PB, PM, b, h, blk, F.wave + 8);
        __syncthreads();
        dil_task<1>(F, H, Y, PB, PM, b, h, blk, F.wave); dil_task<1>(F, H, Y, PB, PM, b, h, blk, F.wave + 8);
        __syncthreads();
    }
}
#undef DMFMA
}

template <bool XBF>
__device__ __forceinline__ void ln_router_phase(const Frame& F, const void* xin_, const bf16_t* Mb, const float* g, const float* bta, const float* rw, const float* rb,
                                                bf16_t* X1B, int* bcnt, const bool dry = false) {
    typedef float f32x16 __attribute__((ext_vector_type(16)));
    LAS int* lcnt = (LAS int*)(F.lds + ROUTE_OFF);
    LAS int* recs = (LAS int*)(F.lds + ROUTE_OFF + 256);
    if (F.tid < NE) lcnt[F.tid] = 0;
    LAS float* pl = (LAS float*)F.lds;
    LAS float* ps = (LAS float*)(F.lds + 32768);
    const int lane = F.lane, r = lane & 31, kh = lane >> 5, tile = F.wave >> 2, kq = F.wave & 3;
    {
        const int row = F.vcu * NWAVES + (r & 7) + F.NGW * (4 * tile + (r >> 3));
        const int k0 = kq * 256 + kh * 128;
        float v[128];
        { const u32x4* mp = (const u32x4*)(Mb + (size_t)row * D_ + k0);
          if (XBF) { const u32x4* xp = (const u32x4*)((const bf16_t*)xin_ + (size_t)row * D_ + k0);
#pragma unroll
              for (int j = 0; j < 16; ++j) { const u32x4 xw = xp[j], mw = mp[j];
                  v[8 * j + 0] = ALPHA * bflo(xw.x) + bflo(mw.x); v[8 * j + 1] = ALPHA * bfhi(xw.x) + bfhi(mw.x); v[8 * j + 2] = ALPHA * bflo(xw.y) + bflo(mw.y); v[8 * j + 3] = ALPHA * bfhi(xw.y) + bfhi(mw.y);
                  v[8 * j + 4] = ALPHA * bflo(xw.z) + bflo(mw.z); v[8 * j + 5] = ALPHA * bfhi(xw.z) + bfhi(mw.z); v[8 * j + 6] = ALPHA * bflo(xw.w) + bflo(mw.w); v[8 * j + 7] = ALPHA * bfhi(xw.w) + bfhi(mw.w); }
          } else { const f32x4* xp = (const f32x4*)((const float*)xin_ + (size_t)row * D_ + k0);
#pragma unroll
              for (int j = 0; j < 16; ++j) { const f32x4 xa = xp[2 * j], xb = xp[2 * j + 1]; const u32x4 mw = mp[j];
                  v[8 * j + 0] = ALPHA * xa[0] + bflo(mw.x); v[8 * j + 1] = ALPHA * xa[1] + bfhi(mw.x); v[8 * j + 2] = ALPHA * xa[2] + bflo(mw.y); v[8 * j + 3] = ALPHA * xa[3] + bfhi(mw.y);
                  v[8 * j + 4] = ALPHA * xb[0] + bflo(mw.z); v[8 * j + 5] = ALPHA * xb[1] + bfhi(mw.z); v[8 * j + 6] = ALPHA * xb[2] + bflo(mw.w); v[8 * j + 7] = ALPHA * xb[3] + bfhi(mw.w); } } }
        float s0 = 0.f, s1 = 0.f, s2 = 0.f, s3 = 0.f;
#pragma unroll
        for (int i = 0; i < 128; i += 4) { s0 += v[i]; s1 += v[i + 1]; s2 += v[i + 2]; s3 += v[i + 3]; }
        float s = (s0 + s1) + (s2 + s3);
        { auto rr = __builtin_amdgcn_permlane32_swap(__float_as_uint(s), __float_as_uint(s), false, false); s = __uint_as_float(rr[0]) + __uint_as_float(rr[1]); }
        if (kh == 0) ps[F.wave * 32 + r] = s;
        __syncthreads();
        const float mean = ((ps[(tile * 4 + 0) * 32 + r] + ps[(tile * 4 + 1) * 32 + r]) + (ps[(tile * 4 + 2) * 32 + r] + ps[(tile * 4 + 3) * 32 + r])) * (1.0f / D_);
        float q0 = 0.f, q1 = 0.f, q2 = 0.f, q3 = 0.f;
#pragma unroll
        for (int i = 0; i < 128; i += 4) { v[i] -= mean; v[i + 1] -= mean; v[i + 2] -= mean; v[i + 3] -= mean; q0 += v[i] * v[i]; q1 += v[i + 1] * v[i + 1]; q2 += v[i + 2] * v[i + 2]; q3 += v[i + 3] * v[i + 3]; }
        float q = (q0 + q1) + (q2 + q3);
        { auto rr = __builtin_amdgcn_permlane32_swap(__float_as_uint(q), __float_as_uint(q), false, false); q = __uint_as_float(rr[0]) + __uint_as_float(rr[1]); }
        if (kh == 0) ps[256 + F.wave * 32 + r] = q;
        __syncthreads();
        const float rstd = rsqrtf(((ps[256 + (tile * 4 + 0) * 32 + r] + ps[256 + (tile * 4 + 1) * 32 + r]) + (ps[256 + (tile * 4 + 2) * 32 + r] + ps[256 + (tile * 4 + 3) * 32 + r])) * (1.0f / D_) + LN_EPS);
        const f32x4* gp = (const f32x4*)(g + k0); const f32x4* bp = (const f32x4*)(bta + k0);
        u32x4* op = (u32x4*)(X1B + (size_t)row * D_ + k0);
#pragma unroll
        for (int c = 0; c < 8; ++c) {
#pragma unroll
            for (int j = 0; j < 4; ++j) { const f32x4 gg = gp[4 * c + j], bb = bp[4 * c + j];
#pragma unroll
                for (int e = 0; e < 4; ++e) v[16 * c + 4 * j + e] = v[16 * c + 4 * j + e] * rstd * gg[e] + bb[e]; }
            u32x4 w0, w1;
            w0.x = pk2(v[16 * c + 0], v[16 * c + 1]); w0.y = pk2(v[16 * c + 2], v[16 * c + 3]); w0.z = pk2(v[16 * c + 4], v[16 * c + 5]); w0.w = pk2(v[16 * c + 6], v[16 * c + 7]);
            w1.x = pk2(v[16 * c + 8], v[16 * c + 9]); w1.y = pk2(v[16 * c + 10], v[16 * c + 11]); w1.z = pk2(v[16 * c + 12], v[16 * c + 13]); w1.w = pk2(v[16 * c + 14], v[16 * c + 15]);
            op[2 * c] = w0; op[2 * c + 1] = w1;
        }
        f32x16 acc = {0.f, 0.f, 0.f, 0.f, 0.f, 0.f, 0.f, 0.f, 0.f, 0.f, 0.f, 0.f, 0.f, 0.f, 0.f, 0.f};
        const float* bptr = rw + (size_t)k0 * NE + r;
        float bq[2][16];
#pragma unroll
        for (int i = 0; i < 16; ++i) bq[0][i] = bptr[i * NE];
#pragma unroll
        for (int c = 0; c < 8; ++c) {
            if (c + 1 < 8) {
#pragma unroll
                for (int i = 0; i < 16; ++i) bq[(c + 1) & 1][i] = bptr[(16 * (c + 1) + i) * NE]; }
#pragma unroll
            for (int i = 0; i < 16; ++i) acc = __builtin_amdgcn_mfma_f32_32x32x2f32(v[16 * c + i], bq[c & 1][i], acc, 0, 0, 0);
            __builtin_amdgcn_sched_barrier(0);
        }
#pragma unroll
        for (int rr = 0; rr < 16; ++rr) pl[(F.wave * 32 + (rr & 3) + 8 * (rr >> 2) + 4 * kh) * 32 + r] = acc[rr];
    }
    __syncthreads();
    for (int it_ = 0; it_ < 8; ++it_) {
        float logit = -INFINITY;
        if (lane < NE) { const LAS float* pp = pl + (((it_ >> 2) * 4) * 32 + (it_ & 3) * 8 + F.wave) * 32 + lane; logit = ((pp[0] + pp[1024]) + (pp[2048] + pp[3072])) + rb[lane]; }
        float tv[TOPK]; int ti[TOPK];
#pragma unroll
        for (int k = 0; k < TOPK; ++k) {
            const float mx = wave_max_u(logit);
            const int bi = (int)__builtin_ctzll(__ballot(logit == mx));
            tv[k] = mx; ti[k] = bi; if (lane == bi) logit = -INFINITY;
        }
        float ex[TOPK], den = 0.f;
#pragma unroll
        for (int k = 0; k < TOPK; ++k) { ex[k] = __expf(tv[k] - tv[0]); den += ex[k]; }
        if (lane < TOPK) {
            int e = ti[0]; float gt = ex[0];
#pragma unroll
            for (int k = 1; k < TOPK; ++k) if (lane == k) { e = ti[k]; gt = ex[k]; }
            const int lr = __hip_atomic_fetch_add((LAS int*)&lcnt[e], 1, __ATOMIC_RELAXED, __HIP_MEMORY_SCOPE_WORKGROUP);
            LAS int* rc = recs + ((F.wave * 8 + it_) * 4 + lane) * 3; rc[0] = e; rc[1] = lr; rc[2] = (int)__float_as_uint(gt / den);
        }
    }
    __syncthreads();
    if (F.tid < NE && !dry) bcnt[F.vcu * NE + F.tid] = lcnt[F.tid];
}

__device__ __forceinline__ int route_fill(const Frame& F, const int* bcnt, int* tk_e, int* tk_rank, float* tk_gate, int* slot_tok) {
    LAS int* tile_e = (LAS int*)(F.lds + TILE_E_OFF); LAS int* tile_f = (LAS int*)(F.lds + TILE_F_OFF); LAS int* ebase = (LAS int*)(F.lds + EBASE_OFF); LAS int* ecnt = (LAS int*)(F.lds + ECNT_OFF);
    LAS int* lbase = (LAS int*)(F.lds + ROUTE_OFF); const LAS int* recs = (const LAS int*)(F.lds + ROUTE_OFF + 256); LAS int* part = (LAS int*)(F.lds + ROUTE_OFF + 3328);
    { const int e = F.tid & 31, p = F.tid >> 5; int sa = 0, sb = 0;
      for (int v = p * 16; v < p * 16 + 16; ++v) if (v < F.G) { const int c = bcnt[v * NE + e]; sa += c; sb += (v < F.vcu) ? c : 0; }
      part[(p * 32 + e) * 2] = sa; part[(p * 32 + e) * 2 + 1] = sb; }
    __syncthreads();
    if (F.tid < NE) { int sa = 0, sb = 0; for (int p = 0; p < 16; ++p) { sa += part[(p * 32 + F.tid) * 2]; sb += part[(p * 32 + F.tid) * 2 + 1]; } ecnt[F.tid] = sa; lbase[F.tid] = sb; }
    __syncthreads();
    if (F.tid == 0) { int run = 0; for (int e = 0; e < NE; ++e) { ebase[e] = run; run += (ecnt[e] + 255) / 256; } ebase[NE] = run; }
    { int it2 = 0; const int lane = F.lane;
      for (int row = F.gw; row < NTOK; row += F.NGW, ++it2) if (lane < TOPK) {
          const LAS int* rc = recs + ((F.wave * 8 + it2) * 4 + lane) * 3; const int e = rc[0], rank = lbase[e] + rc[1];
          tk_e[row * TOPK + lane] = e; tk_rank[row * TOPK + lane] = rank; tk_gate[row * TOPK + lane] = __uint_as_float((unsigned)rc[2]);
          slot_tok[e * NTOK + rank] = row; } }
    __syncthreads();
    const int ntile = ebase[NE];
    for (int tl = F.tid; tl < ntile; tl += NTHR) { int e = 0; while (e + 1 < NE && ebase[e + 1] <= tl) ++e; tile_e[tl] = e; tile_f[tl] = tl - ebase[e]; }
    __syncthreads();
    return ntile;
}

__device__ __forceinline__ void combine_ln_phase(const Frame& F, const bf16_t* X1B, const bf16_t* YA, const int* tk_e, const int* tk_rank, const float* tk_gate,
                                                 const float* g, const float* bta, float* out, bf16_t* XB) {
    const LAS int* ebase = (const LAS int*)(F.lds + EBASE_OFF);
    const int lane = F.lane;
    f32x4 gv[4], bv[4];
#pragma unroll
    for (int j = 0; j < 4; ++j) { gv[j] = *((const f32x4*)g + lane + 64 * j); bv[j] = *((const f32x4*)bta + lane + 64 * j); }
    for (int row0 = F.gw; row0 < NTOK; row0 += 2 * F.NGW) {
        int rows[2]; rows[0] = row0; rows[1] = row0 + F.NGW < NTOK ? row0 + F.NGW : row0;
        const u32x2* yr[2][TOPK]; float gt[2][TOPK];
#pragma unroll
        for (int r = 0; r < 2; ++r)
#pragma unroll
            for (int k = 0; k < TOPK; ++k) { const int e = tk_e[rows[r] * TOPK + k], rk = tk_rank[rows[r] * TOPK + k]; gt[r][k] = tk_gate[rows[r] * TOPK + k];
                yr[r][k] = (const u32x2*)(YA + ((size_t)ebase[e] * 256 + rk) * D_) + lane; }
        u32x2 xw[2][4], yw[2][TOPK][4];
#pragma unroll
        for (int r = 0; r < 2; ++r) { const u32x2* xr = (const u32x2*)(X1B + (size_t)rows[r] * D_) + lane;
#pragma unroll
            for (int j = 0; j < 4; ++j) { xw[r][j] = xr[64 * j];
#pragma unroll
                for (int k = 0; k < TOPK; ++k) yw[r][k][j] = yr[r][k][64 * j]; } }
#pragma unroll
        for (int r = 0; r < 2; ++r) {
            if (r == 1 && rows[1] == rows[0]) break;
            const int row = rows[r];
            f32x4 v[4]; float s = 0.f;
#pragma unroll
            for (int j = 0; j < 4; ++j) { const f32x4 x = {bflo(xw[r][j].x), bfhi(xw[r][j].x), bflo(xw[r][j].y), bfhi(xw[r][j].y)}; f32x4 f = {0.f, 0.f, 0.f, 0.f};
#pragma unroll
                for (int k = 0; k < TOPK; ++k) { const u32x2 w = yw[r][k][j]; f[0] += gt[r][k] * bflo(w.x); f[1] += gt[r][k] * bfhi(w.x); f[2] += gt[r][k] * bflo(w.y); f[3] += gt[r][k] * bfhi(w.y); }
                v[j] = ALPHA * x + f; s += (v[j][0] + v[j][1]) + (v[j][2] + v[j][3]); }
            const float mean = wave_sum_u(s) * (1.0f / D_); float q = 0.f;
#pragma unroll
            for (int j = 0; j < 4; ++j) { v[j] = v[j] - mean; q += (v[j][0] * v[j][0] + v[j][1] * v[j][1]) + (v[j][2] * v[j][2] + v[j][3] * v[j][3]); }
            const float rstd = rsqrtf(wave_sum_u(q) * (1.0f / D_) + LN_EPS);
#pragma unroll
            for (int j = 0; j < 4; ++j) v[j] = v[j] * rstd * gv[j] + bv[j];
            if (out) { f32x4* orow = (f32x4*)(out + (size_t)row * D_) + lane;
#pragma unroll
                for (int j = 0; j < 4; ++j) orow[64 * j] = v[j]; }
            if (XB) { u32x2* xb = (u32x2*)(XB + (size_t)row * D_) + lane;
#pragma unroll
                for (int j = 0; j < 4; ++j) { u32x2 w; w.x = pk2(v[j][0], v[j][1]); w.y = pk2(v[j][2], v[j][3]); xb[64 * j] = w; } }
        }
    }
}

constexpr int PTAB_OFF = CTL_OFF + 4096;
__device__ __forceinline__ const float* ptab_ld(LAS unsigned char* lds, int i) {
    const LAS unsigned* p = (const LAS unsigned*)(lds + PTAB_OFF) + 2 * i;
    const unsigned lo = __builtin_amdgcn_readfirstlane(p[0]), hi = __builtin_amdgcn_readfirstlane(p[1]);
    return (const float*)(((unsigned long long)hi << 32) | lo);
}
#define INP(i) ptab_ld(F.lds, (i))
#define OUTP() ((float*)ptab_ld(F.lds, 31))
#define WSP() ((unsigned char*)ptab_ld(F.lds, 32))
#define LAUNDER_S(x) do { int _v = (x); asm volatile("" : "+v"(_v)); (x) = __builtin_amdgcn_readfirstlane(_v); } while (0)
#define PHASE_BEGIN() do { LAUNDER_S(F.G); LAUNDER_S(F.vcu); LAUNDER_S(F.gw); LAUNDER_S(F.NGW); LAUNDER_S(F.wave); LAUNDER_S(F.bx); \
        { int _o = -1; asm volatile("" : "+v"(_o)); const unsigned _m = (unsigned)__builtin_amdgcn_readfirstlane(_o); F.lane = (int)__builtin_amdgcn_mbcnt_hi(_m, __builtin_amdgcn_mbcnt_lo(_m, 0u)); F.tid = F.wave * 64 + F.lane; } \
        { unsigned _l = (unsigned)(uintptr_t)F.lds; asm volatile("" : "+v"(_l)); F.lds = (LAS unsigned char*)(uintptr_t)(unsigned)__builtin_amdgcn_readfirstlane((int)_l); } } while (0)
#define GRID_BAR() xcd_barrier(bar, F.wave == 0 && fresh_lane() == 0)
#define TILE_E ((const LAS int*)(F.lds + TILE_E_OFF))
#define TILE_F ((const LAS int*)(F.lds + TILE_F_OFF))
#define ECNT ((const LAS int*)(F.lds + ECNT_OFF))
template <int layer>
__device__ __forceinline__ void run_layer(Frame& F, const XcdBarrier& bar) {
        const int lb = layer == 0 ? 0 : 17;
        const int NP = layer == 0 ? EVEN_PAD : ODD_IN;
        constexpr size_t WOFF = layer == 0 ? 0 : WS_W1OFF;
        constexpr int TAIL_BATCHES = 3;
        PHASE_BEGIN();
        { unsigned char* ws = WSP(); pg8::DenseSched S; S.init(ws + WS_XB, ws + WOFF + WS_WIN, NTOK, NP, D_, F.G, F.bx); pg8::EpiBf16 E{(bf16_t*)(ws + WS_H), NP};
          pg8::gemm_phase<pg8::EpiBf16, pg8::DenseSched, false>(F.lds, D_, S, E, F.tid); }
        if (layer == 0) { const int nu_ = (NTOK / 256) * (NP / 256), my_ = (nu_ - F.bx + F.G - 1) / F.G, mx_ = (nu_ + F.G - 1) / F.G;
          if (my_ < mx_) { ConvJob J{INP(14), ODD_IN, ODD_IN, INP(20), INP(25), INP(27), WS_W1OFF}; convert_queue(F, J, (int*)(WSP() + WS_CTL) + CW_CONV, (mx_ - my_) * TAIL_BATCHES); } }
        GRID_BAR();
        PHASE_BEGIN();
        { unsigned char* ws = WSP();
          if (layer == 0) { conv_phase(F, (const bf16_t*)(ws + WS_H), INP(2), (bf16_t*)(ws + WS_Y));
                            { ConvJob J0{INP(1), EVEN_IN, EVEN_PAD, INP(3), INP(8), INP(10), 0};
                              dsa_select_phase(F, (const bf16_t*)(ws + WS_H), (unsigned long long*)(ws + WS_X1), J0, (int*)(ws + WS_CTL) + CW_CONV + 64, 16 * (EVEN_PAD / 64) + 256); } }
          else { diff_attn_phase(F, (const bf16_t*)(ws + WS_H), (bf16_t*)(ws + WS_MB));
                 dil::dil_phase(F, (const bf16_t*)(ws + WS_H), (bf16_t*)(ws + WS_Y), (float*)(ws + WS_YA)); } }
        GRID_BAR();
        if (layer == 0) { PHASE_BEGIN(); unsigned char* ws = WSP();
          dsa_attn_phase(F, (const bf16_t*)(ws + WS_H), (const unsigned long long*)(ws + WS_X1), (bf16_t*)(ws + WS_Y));
          GRID_BAR(); }
        if (layer == 1) { PHASE_BEGIN(); unsigned char* ws = WSP();
          diff_combine_phase(F, (const bf16_t*)(ws + WS_MB), INP(15), INP(16), INP(17), INP(18), INP(19), (bf16_t*)(ws + WS_Y));
          GRID_BAR(); }
        PHASE_BEGIN();
        { unsigned char* ws = WSP(); pg8::DenseSched S; S.init(ws + WS_Y, ws + WOFF + WS_WOUT, NTOK, D_, D_, F.G, F.bx); pg8::EpiBf16 E{(bf16_t*)(ws + WS_MB), D_};
          pg8::gemm_phase<pg8::EpiBf16, pg8::DenseSched, false>(F.lds, D_, S, E, F.tid); }
        GRID_BAR();
        PHASE_BEGIN();
        { unsigned char* ws = WSP();
          ln_router_phase<layer == 1>(F, layer == 0 ? (const void*)INP(0) : (const void*)(ws + WS_XB), (const bf16_t*)(ws + WS_MB), INP(4 + lb), INP(5 + lb), INP(6 + lb), INP(7 + lb),
                          (bf16_t*)(ws + WS_X1B), (int*)(ws + WS_CTL) + CW_BCNT); }
        GRID_BAR();
        PHASE_BEGIN();
        int ntile;
        { unsigned char* ws = WSP();
          ntile = route_fill(F, (const int*)(ws + WS_CTL) + CW_BCNT, (int*)(ws + WS_TKE), (int*)(ws + WS_TKR), (float*)(ws + WS_TKG), (int*)(ws + WS_SLOT)); }
        if (layer == 0) { ConvJob J0{INP(1), EVEN_IN, EVEN_PAD, INP(3), INP(8), INP(10), 0};
          convert_queue(F, J0, (int*)(WSP() + WS_CTL) + CW_CONV + 64, 1 << 30, 1, 16 * (EVEN_PAD / 64) + 256); }
        GRID_BAR();
        PHASE_BEGIN();
        { unsigned char* ws = WSP(); pg8::MoeSched S; S.A = (const char*)(ws + WS_X1B); S.Bt = (const char*)(ws + WOFF + WS_WGU); S.slot_tok = (const int*)(ws + WS_SLOT); S.tile_e = TILE_E; S.tile_f = TILE_F; S.ecnt = ECNT;
          S.NPN = 8; S.n_units = ntile * 8; S.G = F.G; S.c = F.bx; S.bexp = (size_t)2 * DFF * D_ * 2; S.gather = true;
          pg8::EpiAct E{(bf16_t*)(ws + WS_ACT), INP(9 + lb), TILE_E};
          pg8::gemm_phase<pg8::EpiAct, pg8::MoeSched, true>(F.lds, D_, S, E, F.tid); }
        if (layer == 0) { pg8::MoeSched S_; S_.NPN = 8; S_.n_units = ntile * 8; S_.G = F.G; S_.c = F.bx; const int nu_ = ntile * 8, my_ = S_.my_units(), mx_ = (nu_ + F.G - 1) / F.G;
          if (my_ < mx_) { ConvJob J{INP(14), ODD_IN, ODD_IN, INP(20), INP(25), INP(27), WS_W1OFF}; convert_queue(F, J, (int*)(WSP() + WS_CTL) + CW_CONV, (mx_ - my_) * TAIL_BATCHES); } }
        GRID_BAR();
        PHASE_BEGIN();
        { unsigned char* ws = WSP(); pg8::MoeSched S; S.A = (const char*)(ws + WS_ACT); S.Bt = (const char*)(ws + WOFF + WS_WDN); S.slot_tok = (const int*)(ws + WS_SLOT); S.tile_e = TILE_E; S.tile_f = TILE_F; S.ecnt = ECNT;
          S.NPN = 4; S.n_units = ntile * 4; S.G = F.G; S.c = F.bx; S.bexp = (size_t)D_ * DFF * 2; S.gather = false;
          pg8::EpiBias E{(bf16_t*)(ws + WS_YA), INP(11 + lb), TILE_E};
          pg8::gemm_phase<pg8::EpiBias, pg8::MoeSched, false>(F.lds, DFF, S, E, F.tid); }
        if (layer == 0) { pg8::MoeSched S_; S_.NPN = 4; S_.n_units = ntile * 4; S_.G = F.G; S_.c = F.bx; const int nu_ = ntile * 4, my_ = S_.my_units(), mx_ = (nu_ + F.G - 1) / F.G;
          if (my_ < mx_) { ConvJob J{INP(14), ODD_IN, ODD_IN, INP(20), INP(25), INP(27), WS_W1OFF}; convert_queue(F, J, (int*)(WSP() + WS_CTL) + CW_CONV, (mx_ - my_) * TAIL_BATCHES); } }
        GRID_BAR();
        PHASE_BEGIN();
        { unsigned char* ws = WSP();
          combine_ln_phase(F, (const bf16_t*)(ws + WS_X1B), (const bf16_t*)(ws + WS_YA), (const int*)(ws + WS_TKE), (const int*)(ws + WS_TKR), (const float*)(ws + WS_TKG),
                           INP(12 + lb), INP(13 + lb), layer == 0 ? (float*)nullptr : OUTP(), layer == 0 ? (bf16_t*)(ws + WS_XB) : nullptr); }
        if (layer == 0) {
            __syncthreads();
            PHASE_BEGIN();
            { ConvJob J{INP(14), ODD_IN, ODD_IN, INP(20), INP(25), INP(27), WS_W1OFF}; convert_queue(F, J, (int*)(WSP() + WS_CTL) + CW_CONV, 1 << 30, 1); }
            GRID_BAR();
        }
}

__global__ void __launch_bounds__(NTHR, 2) mega_fwd(Args args) {
    extern __shared__ __attribute__((aligned(16))) unsigned char lds_raw[];
    Frame F;
    F.lds = (LAS unsigned char*)lds_raw;
    F.tid = threadIdx.x; F.lane = F.tid & 63; F.wave = __builtin_amdgcn_readfirstlane(F.tid >> 6);
    F.G = gridDim.x; F.bx = blockIdx.x; { const int bx = blockIdx.x; F.vcu = (F.G % 8 == 0) ? (bx % 8) * (F.G / 8) + bx / 8 : bx; }
    F.gw = F.vcu * NWAVES + F.wave; F.NGW = F.G * NWAVES;
    for (int u = F.tid; u < (LDS_BYTES - CTL_OFF) / 4; u += NTHR) ((LAS unsigned*)(F.lds + CTL_OFF))[u] = 0u;
    __syncthreads();
    if (F.tid == 0) {
        LAS unsigned long long* pt = (LAS unsigned long long*)(F.lds + PTAB_OFF);
#pragma unroll
        for (int i = 0; i < 31; ++i) pt[i] = (unsigned long long)args.in[i];
        pt[31] = (unsigned long long)args.out; pt[32] = (unsigned long long)args.ws;
    }
    __syncthreads();
    F.ws = WSP();
    XcdBarrier bar = xcd_barrier_post((unsigned*)(WSP() + WS_CTL) + CW_BAR, (volatile LAS unsigned*)(F.lds + MISC_OFF) + 8);

    { ConvJob J{INP(1), EVEN_IN, EVEN_PAD, INP(3), INP(8), INP(10), 0}; convert_weights(F, J, 16 * (EVEN_PAD / 64) + 256); }
    convert_x(F, INP(0), (bf16_t*)(WSP() + WS_XB));
    if (gridDim.x == 0x7fffffffu) cg::this_grid().sync();
    GRID_BAR();

    run_layer<0>(F, bar);
    run_layer<1>(F, bar);
}

extern "C" void kernel_launch(void* const* d_in, const int* in_sizes, int n_in, void* d_out, int out_size, void* d_ws, size_t ws_size, hipStream_t stream) {
    (void)in_sizes; (void)out_size;
    static int grid = 0;
    if (grid == 0) {
        if (n_in != 31 || ws_size < WS_END) { fprintf(stderr, "kernel_launch: unexpected n_in %d or ws_size %zu\n", n_in, ws_size); grid = -1; return; }
        int dev = 0, cus = 0, per_cu = 0;
        if (hipGetDevice(&dev) != hipSuccess || hipDeviceGetAttribute(&cus, hipDeviceAttributeMultiprocessorCount, dev) != hipSuccess) { grid = -1; return; }
        if (hipFuncSetAttribute((const void*)mega_fwd, hipFuncAttributeMaxDynamicSharedMemorySize, LDS_BYTES) != hipSuccess) { fprintf(stderr, "kernel_launch: hipFuncSetAttribute failed\n"); grid = -1; return; }
        if (hipOccupancyMaxActiveBlocksPerMultiprocessor(&per_cu, (const void*)mega_fwd, NTHR, LDS_BYTES) != hipSuccess || per_cu < 1) { fprintf(stderr, "kernel_launch: occupancy query says %d\n", per_cu); per_cu = 1; }
        (void)hipGetLastError();
        grid = cus;
    }
    if (grid < 0) return;
    if (hipMemsetAsync((char*)d_ws + WS_CTL, 0, CTL_ZERO_BYTES, stream) != hipSuccess) return;
    Args a{};
    for (int i = 0; i < 31; ++i) a.in[i] = (const float*)d_in[i];
    a.out = (float*)d_out; a.ws = (unsigned char*)d_ws;
    void* kargs[] = {&a};
    hipError_t e = hipLaunchCooperativeKernel((const void*)mega_fwd, dim3(grid), dim3(NTHR), kargs, LDS_BYTES, stream);
    if (e != hipSuccess) fprintf(stderr, "kernel_launch: cooperative launch failed: %s (grid %d)\n", hipGetErrorString(e), grid);
}
```

```cpp
#include <hip/hip_runtime.h>
#include <hip/hip_cooperative_groups.h>
#include <cstdio>
#include <cstdint>
#include <cmath>
namespace cg = cooperative_groups;

#define LAS __attribute__((address_space(3)))
#define GAS __attribute__((address_space(1)))
typedef unsigned short bf16_t;
typedef short bf16x8 __attribute__((ext_vector_type(8)));
typedef float f32x4 __attribute__((ext_vector_type(4)));
typedef float f32x2 __attribute__((ext_vector_type(2)));
typedef unsigned u32x4 __attribute__((ext_vector_type(4)));
typedef unsigned u32x2 __attribute__((ext_vector_type(2)));

constexpr int B_ = 4, S_ = 4096, D_ = 1024, NTOK = B_ * S_;
constexpr int EVEN_IN = 3368, EVEN_PAD = 3584, ODD_IN = 3072;
constexpr int NE = 32, TOPK = 4, DFF = 1024;
constexpr float ALPHA = 1.41421356237f;
constexpr float LN_EPS = 1e-5f, RMS_EPS = 1e-5f;
constexpr int MAXTILES = NTOK * TOPK / 256 + NE;
constexpr int MAXROWS = MAXTILES * 256;
constexpr int E_GB = 0, E_GC = 512, E_XA = 1024, E_Q = 1536, E_K = 2048, E_V = 2560, E_IQ = 3072, E_IK = 3328, E_IW = 3360;
constexpr int O_QC = 0, O_KC = 512, O_VC = 1024, O_QD = 1536, O_KD = 2048, O_VD = 2560;
constexpr int NWAVES = 8, NTHR = 512;

constexpr size_t MiB = 1u << 20;
constexpr size_t WS_CTL = 0, CTL_ZERO_BYTES = 1 * MiB;
constexpr size_t WS_SLOT = 2 * MiB;
constexpr size_t WS_TKE = 4 * MiB, WS_TKR = 5 * MiB, WS_TKG = 6 * MiB;
constexpr size_t WS_WIN = 8 * MiB, WS_WOUT = 16 * MiB, WS_WGU = 18 * MiB, WS_WDN = 146 * MiB;
constexpr size_t WS_XB = 210 * MiB;
constexpr size_t WS_H = 242 * MiB;
constexpr size_t WS_Y = 354 * MiB;
constexpr size_t WS_MB = 386 * MiB;
constexpr size_t WS_ACT = 242 * MiB;
constexpr size_t WS_YA = 418 * MiB;
constexpr size_t WS_X1 = 562 * MiB;
constexpr size_t WS_X1B = 626 * MiB;
constexpr size_t WS_X2 = 658 * MiB;
constexpr size_t WS_W1OFF = 714 * MiB;
constexpr size_t WS_END = 924 * MiB;
constexpr int CW_BAR = 4096;
constexpr int CW_CONV = 80000;
constexpr int CW_BCNT = 65536;

constexpr int RING_BYTES = 131072;
constexpr int CTL_OFF = RING_BYTES, MISC_OFF = CTL_OFF + 320, TILE_E_OFF = CTL_OFF + 1024, TILE_F_OFF = CTL_OFF + 2304, EBASE_OFF = CTL_OFF + 3584, ECNT_OFF = CTL_OFF + 3744;
constexpr int ROUTE_OFF = CTL_OFF + 6144;
constexpr int LDS_BYTES = 147456;

#define LDS_WAIT() asm volatile("s_waitcnt lgkmcnt(0)" ::: "memory")
#define VM_WAIT() asm volatile("s_waitcnt vmcnt(0)" ::: "memory")
__device__ __forceinline__ unsigned f2bf(float f) { unsigned u = __builtin_bit_cast(unsigned, f); return (u + 0x7fffu + ((u >> 16) & 1u)) >> 16; }
__device__ __forceinline__ unsigned pk2(float lo, float hi) { return f2bf(lo) | (f2bf(hi) << 16); }
__device__ __forceinline__ float bf2f(unsigned h) { return __builtin_bit_cast(float, h << 16); }
__device__ __forceinline__ float bflo(unsigned w) { return __builtin_bit_cast(float, w << 16); }
__device__ __forceinline__ float bfhi(unsigned w) { return __builtin_bit_cast(float, w & 0xffff0000u); }
__device__ __forceinline__ float wave_sum(float v) {
#pragma unroll
    for (int o = 1; o < 64; o <<= 1) v += __shfl_xor(v, o);
    return v;
}
__device__ __forceinline__ float wave_max(float v) {
#pragma unroll
    for (int o = 1; o < 64; o <<= 1) v = fmaxf(v, __shfl_xor(v, o));
    return v;
}
template <int CTRL, int ROWMASK> __device__ __forceinline__ float dpp_mov(float v, float old) { return __builtin_bit_cast(float, __builtin_amdgcn_update_dpp(__builtin_bit_cast(int, old), __builtin_bit_cast(int, v), CTRL, ROWMASK, 0xF, false)); }
__device__ __forceinline__ float wave_sum_u(float v) {
    v += dpp_mov<0xB1, 0xF>(v, 0.f); v += dpp_mov<0x4E, 0xF>(v, 0.f); v += dpp_mov<0x141, 0xF>(v, 0.f); v += dpp_mov<0x140, 0xF>(v, 0.f);
    v += dpp_mov<0x142, 0xA>(v, 0.f); v += dpp_mov<0x143, 0xC>(v, 0.f);
    return __builtin_bit_cast(float, __builtin_amdgcn_readlane(__builtin_bit_cast(int, v), 63));
}
__device__ __forceinline__ float wave_max_u(float v) {
    const float ninf = -INFINITY;
    v = fmaxf(v, dpp_mov<0xB1, 0xF>(v, ninf)); v = fmaxf(v, dpp_mov<0x4E, 0xF>(v, ninf)); v = fmaxf(v, dpp_mov<0x141, 0xF>(v, ninf)); v = fmaxf(v, dpp_mov<0x140, 0xF>(v, ninf));
    v = fmaxf(v, dpp_mov<0x142, 0xA>(v, ninf)); v = fmaxf(v, dpp_mov<0x143, 0xC>(v, ninf));
    return __builtin_bit_cast(float, __builtin_amdgcn_readlane(__builtin_bit_cast(int, v), 63));
}
__device__ __forceinline__ int wave_sum_iu(int v) {
#define DPPI(x, C, M) __builtin_amdgcn_update_dpp(0, (x), C, M, 0xF, false)
    v += DPPI(v, 0xB1, 0xF); v += DPPI(v, 0x4E, 0xF); v += DPPI(v, 0x141, 0xF); v += DPPI(v, 0x140, 0xF); v += DPPI(v, 0x142, 0xA); v += DPPI(v, 0x143, 0xC);
#undef DPPI
    return __builtin_amdgcn_readlane(v, 63);
}
__device__ __forceinline__ unsigned cvt_pk_bf16(float lo, float hi) { unsigned r; asm volatile("v_cvt_pk_bf16_f32 %0, %1, %2" : "=v"(r) : "v"(lo), "v"(hi)); return r; }

__device__ __forceinline__ int fresh_lane() { int o_ = -1; asm volatile("" : "+v"(o_)); const unsigned m_ = (unsigned)__builtin_amdgcn_readfirstlane(o_); return (int)__builtin_amdgcn_mbcnt_hi(m_, __builtin_amdgcn_mbcnt_lo(m_, 0u)); }
namespace pg8 {
constexpr int BM = 256, BK = 64, HALF = 128, HTB = HALF * BK * 2, STAGE_BYTES = 8 * HTB, NXCD = 8, WGM = 8;
__host__ __device__ __forceinline__ int lds_byte(int r, int c) { const int st = (r >> 4) * 2 + (c >> 5), rr = r & 15, cc = c & 31, ob = rr * 64 + cc * 2; return st * 1024 + (ob ^ (((ob >> 9) & 1) << 5)); }
__host__ __device__ __forceinline__ void stage_rc(int b, int& R, int& C) { const int st = b / 1024, sb = b % 1024, swz = sb ^ (((sb >> 9) & 1) << 5); R = (st >> 1) * 16 + swz / 64; C = (st & 1) * 32 + (swz % 64) / 2; }
__host__ __device__ __forceinline__ int perm32(int rho) { const int n = rho >> 4, i = rho & 15; return 8 * (i >> 2) + 4 * n + (i & 3); }
struct Unit { int pm, pn; };

struct DenseSched {
    const char* A; const char* Bt; int nM, nN, nwg, G, c; size_t tstep;
    __device__ void init(const void* A_, const void* Bt_, int M, int N, int K, int G_, int c_) { A = (const char*)A_; Bt = (const char*)Bt_; nM = M / BM; nN = N / BM; nwg = nM * nN; G = G_; c = c_; tstep = (size_t)BM * K * 2; }
    __device__ bool next(int i, Unit& u) const {
        const long L = (long)i * G + c; if (L >= nwg) return false;
        int wgid = (int)L; { const int q = nwg / NXCD, r = nwg % NXCD, xcd = wgid % NXCD, off = wgid / NXCD; wgid = (xcd < r ? xcd * (q + 1) : r * (q + 1) + (xcd - r) * q) + off; }
        const int nig = WGM * nN, gid = wgid / nig, fm = gid * WGM, gsz = (nM - fm) < WGM ? (nM - fm) : WGM;
        u.pm = fm + ((wgid % nig) % gsz); u.pn = (wgid % nig) / gsz; return true;
    }
    __device__ __forceinline__ const char* a_base(const Unit& u) const { return A + (size_t)u.pm * tstep; }
    __device__ __forceinline__ const char* b_base(const Unit& u) const { return Bt + (size_t)u.pn * tstep; }
    __device__ __forceinline__ unsigned row_off(const Unit&, int) const { return 0u; }
};
struct MoeSched {
    const char* A; const char* Bt; const int* slot_tok; const LAS int* tile_e; const LAS int* tile_f; const LAS int* ecnt;
    int n_units, NPN, G, c; size_t bexp; bool gather;
    __device__ __forceinline__ int tile_off() const { return (c % NXCD) * (G / NXCD / NPN) + (c / NXCD) / NPN; }
    __device__ bool next(int i, Unit& u) const {
        if (G % (NXCD * NPN) != 0) { const long L = (long)i * G + c; if (L >= n_units) return false; u.pm = (int)(L / NPN); u.pn = (int)(L % NPN); return true; }
        const int pm = i * (G / NPN) + tile_off(); if (pm >= n_units / NPN) return false; u.pm = pm; u.pn = (c / NXCD) % NPN; return true; }
    __device__ __forceinline__ int my_units() const { if (G % (NXCD * NPN) != 0) return (int)((n_units - c + G - 1) / G); const int nt_ = n_units / NPN, o = tile_off(), tpr = G / NPN; return o < nt_ ? (nt_ - o + tpr - 1) / tpr : 0; }
    __device__ __forceinline__ const char* a_base(const Unit& u) const { return gather ? A : A + (size_t)u.pm * ((size_t)BM * 1024 * 2); }
    __device__ __forceinline__ const char* b_base(const Unit& u) const { return Bt + (size_t)tile_e[u.pm] * bexp + (size_t)u.pn * ((size_t)BM * 1024 * 2); }
    __device__ __forceinline__ unsigned row_off(const Unit& u, int r) const {
        const int e = tile_e[u.pm], rk = tile_f[u.pm] * BM + r; const int tok = rk < ecnt[e] ? slot_tok[e * NTOK + rk] : 0;
        return (unsigned)tok * 2048u;
    }
};

struct EpiBf16 {
    static constexpr bool PERM = true;
    bf16_t* O; int ldc;
    __device__ __forceinline__ void operator()(const f32x4 (&acc)[2][2][4][2], const Unit& u, int wr, int wc, int fr, int fq) const {
        const int row0 = u.pm * BM + wr * 64 + fr, col0 = u.pn * BM + wc * 32 + 8 * fq;
#pragma unroll
        for (int ai = 0; ai < 2; ++ai)
#pragma unroll
            for (int m = 0; m < 4; ++m) { bf16_t* rowp = O + (size_t)(row0 + ai * HALF + m * 16) * ldc + col0;
#pragma unroll
                for (int bj = 0; bj < 2; ++bj) { const f32x4 v0 = acc[ai][bj][m][0], v1 = acc[ai][bj][m][1];
                    u32x4 w; w.x = cvt_pk_bf16(v0[0], v0[1]); w.y = cvt_pk_bf16(v0[2], v0[3]); w.z = cvt_pk_bf16(v1[0], v1[1]); w.w = cvt_pk_bf16(v1[2], v1[3]);
                    *(u32x4*)(rowp + bj * HALF) = w; } }
    }
};
struct EpiAct {
    static constexpr bool PERM = true;
    bf16_t* O; const float* bias; const LAS int* tile_e;
    __device__ __forceinline__ void operator()(const f32x4 (&acc)[2][2][4][2], const Unit& u, int wr, int wc, int fr, int fq) const {
        const int e = tile_e[u.pm];
        const float* bg = bias + (size_t)e * 2 * DFF + u.pn * HALF + wc * 32 + 8 * fq;
        const f32x4 bg0 = *(const f32x4*)bg, bg1 = *(const f32x4*)(bg + 4), bu0 = *(const f32x4*)(bg + DFF), bu1 = *(const f32x4*)(bg + DFF + 4);
        const int row0 = u.pm * BM + wr * 64 + fr, col0 = u.pn * HALF + wc * 32 + 8 * fq;
#pragma unroll
        for (int ai = 0; ai < 2; ++ai)
#pragma unroll
            for (int m = 0; m < 4; ++m) {
                f32x4 g0 = acc[ai][0][m][0] + bg0, g1 = acc[ai][0][m][1] + bg1, u0 = acc[ai][1][m][0] + bu0, u1 = acc[ai][1][m][1] + bu1;
                float r[8];
#pragma unroll
                for (int j = 0; j < 8; ++j) { float gt = j < 4 ? g0[j & 3] : g1[j & 3], up = j < 4 ? u0[j & 3] : u1[j & 3];
                    gt = fminf(gt, 7.0f); up = fminf(fmaxf(up, -7.0f), 7.0f);
                    const float sg = __builtin_amdgcn_rcpf(1.0f + __builtin_amdgcn_exp2f(-1.702f * 1.4426950408889634f * gt));
                    r[j] = (up + 1.0f) * (gt * sg); }
                u32x4 w; w.x = cvt_pk_bf16(r[0], r[1]); w.y = cvt_pk_bf16(r[2], r[3]); w.z = cvt_pk_bf16(r[4], r[5]); w.w = cvt_pk_bf16(r[6], r[7]);
                *(u32x4*)(O + (size_t)(row0 + ai * HALF + m * 16) * DFF + col0) = w; }
    }
};
struct EpiBias {
    static constexpr bool PERM = true;
    bf16_t* O; const float* bias; const LAS int* tile_e;
    __device__ __forceinline__ void operator()(const f32x4 (&acc)[2][2][4][2], const Unit& u, int wr, int wc, int fr, int fq) const {
        const int e = tile_e[u.pm];
        const int row0 = u.pm * BM + wr * 64 + fr, col0 = u.pn * BM + wc * 32 + 8 * fq;
        const float* bp = bias + (size_t)e * D_ + col0;
        f32x4 bv[2][2];
#pragma unroll
        for (int bj = 0; bj < 2; ++bj)
#pragma unroll
            for (int n = 0; n < 2; ++n) bv[bj][n] = *(const f32x4*)(bp + bj * HALF + 4 * n);
#pragma unroll
        for (int ai = 0; ai < 2; ++ai)
#pragma unroll
            for (int m = 0; m < 4; ++m) { bf16_t* rowp = O + (size_t)(row0 + ai * HALF + m * 16) * D_ + col0;
#pragma unroll
                for (int bj = 0; bj < 2; ++bj) { const f32x4 v0 = acc[ai][bj][m][0] + bv[bj][0], v1 = acc[ai][bj][m][1] + bv[bj][1];
                    u32x4 w; w.x = cvt_pk_bf16(v0[0], v0[1]); w.y = cvt_pk_bf16(v0[2], v0[3]); w.z = cvt_pk_bf16(v1[0], v1[1]); w.w = cvt_pk_bf16(v1[2], v1[3]);
                    *(u32x4*)(rowp + bj * HALF) = w; } }
    }
};

template <class Epi, class Sched, bool GATHER>
__device__ __forceinline__ void gemm_phase(LAS unsigned char* lds, const int K, const Sched& S, const Epi& E, const int tid) {
    const int wid = __builtin_amdgcn_readfirstlane(tid >> 6), lane = tid & 63, wr = wid >> 2, wc = wid & 3, fr = lane & 15, fq = lane >> 4;
    const int nt = K / BK;
    unsigned voffA[2], voffB[2]; int RA[2], CA2[2];
#pragma unroll
    for (int i = 0; i < 2; ++i) { int R, C; stage_rc(tid * 16 + i * 8192, R, C); const int Rb = Epi::PERM ? ((R & ~31) + perm32(R & 31)) : R;
        voffA[i] = (unsigned)(R * K + C) * 2u; voffB[i] = (unsigned)(Rb * K + C) * 2u; RA[i] = R; CA2[i] = C * 2; }
    const size_t kstep = (size_t)(BK * 2);
    const size_t hstep = (size_t)HALF * K * 2;
    const unsigned ldsw = (unsigned)wid * 1024u;
    const int aoff = lds_byte(wr * 64 + fr, fq * 8), boff = lds_byte(wc * 32 + fr, fq * 8);
#define PG8_SA(b, h) (((b) * 2 + (h)) * HTB)
#define PG8_SB(b, h) ((4 + (b) * 2 + (h)) * HTB)
#define PG8_STAGE(bufoff, gbase, voff) do { _Pragma("unroll") for (int _i = 0; _i < 2; ++_i) \
        __builtin_amdgcn_global_load_lds((const unsigned*)((const char*)(gbase) + (voff)[_i]), (LAS unsigned*)(lds + (bufoff) + ldsw + _i * 8192), 16, 0, 0); } while (0)
#define PG8_STAGE_A(bufoff, gbase, h, vg) do { if constexpr (GATHER) { PG8_STAGE(bufoff, gbase, (vg)[h]); } else { PG8_STAGE(bufoff, (gbase) + (h) * hstep, voffA); } } while (0)
#define PG8_LDA(dst, b, h) do { _Pragma("unroll") for (int m = 0; m < 4; ++m) _Pragma("unroll") for (int k = 0; k < 2; ++k) dst[m][k] = *(const LAS bf16x8*)(lds + PG8_SA(b, h) + aoff + m * 2048 + k * 1024); } while (0)
#define PG8_LDB(dst, b, h) do { _Pragma("unroll") for (int n = 0; n < 2; ++n) _Pragma("unroll") for (int k = 0; k < 2; ++k) dst[n][k] = *(const LAS bf16x8*)(lds + PG8_SB(b, h) + boff + n * 2048 + k * 1024); } while (0)
#define PG8_MMA(ai, bj, At, Bt) do { __builtin_amdgcn_s_setprio(1); _Pragma("unroll") for (int m = 0; m < 4; ++m) _Pragma("unroll") for (int n = 0; n < 2; ++n) _Pragma("unroll") for (int k = 0; k < 2; ++k) \
        acc[ai][bj][m][n] = __builtin_amdgcn_mfma_f32_16x16x32_bf16(Bt[n][k], At[m][k], acc[ai][bj][m][n], 0, 0, 0); __builtin_amdgcn_s_setprio(0); } while (0)
#define PG8_WAIT_V(n) asm volatile("s_waitcnt vmcnt(" #n ")" ::: "memory")
#define PG8_WAIT_L(n) asm volatile("s_waitcnt lgkmcnt(" #n ")" ::: "memory")
#define PG8_BAR __builtin_amdgcn_s_barrier()
#define PG8_SCHED __builtin_amdgcn_sched_barrier(0)
    Unit cur, nxt; int ui = 0;
    if (!S.next(0, cur)) return;
    f32x4 acc[2][2][4][2];
#pragma unroll
    for (int a = 0; a < 2; ++a)
#pragma unroll
        for (int b = 0; b < 2; ++b)
#pragma unroll
            for (int m = 0; m < 4; ++m)
#pragma unroll
                for (int n = 0; n < 2; ++n) acc[a][b][m][n] = (f32x4){0.f, 0.f, 0.f, 0.f};
    bf16x8 At[4][2], B0[2][2], B1[2][2];
    unsigned vgc[2][2] = {{0u, 0u}, {0u, 0u}}, vgn[2][2] = {{0u, 0u}, {0u, 0u}};
    if constexpr (GATHER) {
#pragma unroll
        for (int h = 0; h < 2; ++h)
#pragma unroll
            for (int i = 0; i < 2; ++i) vgc[h][i] = S.row_off(cur, h * HALF + RA[i]) + (unsigned)CA2[i];
    }
    const char* cA = S.a_base(cur); const char* cB = S.b_base(cur);
    PG8_STAGE(PG8_SB(0, 0), cB, voffB); PG8_STAGE(PG8_SB(0, 1), cB + hstep, voffB); PG8_STAGE_A(PG8_SA(0, 0), cA, 0, vgc); PG8_STAGE_A(PG8_SA(0, 1), cA, 1, vgc);
    if (wr == 1) PG8_BAR;
    PG8_WAIT_V(2); PG8_BAR;
    PG8_STAGE(PG8_SB(1, 0), cB + kstep, voffB); PG8_STAGE_A(PG8_SA(1, 0), cA + kstep, 0, vgc); PG8_STAGE(PG8_SB(1, 1), cB + hstep + kstep, voffB);
    PG8_WAIT_V(6); PG8_BAR;
    for (;;) {
        const bool has_next = S.next(ui + 1, nxt);
        const char* nA = has_next ? S.a_base(nxt) : cA; const char* nB = has_next ? S.b_base(nxt) : cB;
        if constexpr (GATHER) {
            if (has_next) {
#pragma unroll
                for (int h = 0; h < 2; ++h)
#pragma unroll
                    for (int i = 0; i < 2; ++i) vgn[h][i] = S.row_off(nxt, h * HALF + RA[i]) + (unsigned)CA2[i];
            } else {
#pragma unroll
                for (int h = 0; h < 2; ++h)
#pragma unroll
                    for (int i = 0; i < 2; ++i) vgn[h][i] = vgc[h][i];
            }
        }
        for (int t = 0; t < nt; t += 2) {
            const bool last = (t == nt - 2);
            const char* a1 = cA + (size_t)(t + 1) * kstep;
            const char* a2 = last ? nA : cA + (size_t)(t + 2) * kstep; const char* b2 = last ? nB : cB + (size_t)(t + 2) * kstep;
            const char* a3 = a2 + kstep; const char* b3 = b2 + kstep;
            unsigned vg2[2][2];
#pragma unroll
            for (int h = 0; h < 2; ++h)
#pragma unroll
                for (int i = 0; i < 2; ++i) vg2[h][i] = last ? vgn[h][i] : vgc[h][i];
            PG8_LDB(B0, 0, 0); PG8_LDB(B1, 0, 1); PG8_SCHED; PG8_LDA(At, 0, 0); PG8_STAGE_A(PG8_SA(1, 1), a1, 1, vgc);
            PG8_WAIT_V(8); PG8_WAIT_L(0); PG8_BAR; PG8_MMA(0, 0, At, B0); PG8_MMA(0, 1, At, B1); PG8_BAR; PG8_SCHED;
            PG8_LDA(At, 0, 1); PG8_STAGE(PG8_SB(0, 0), b2, voffB); PG8_STAGE(PG8_SB(0, 1), b2 + hstep, voffB); PG8_STAGE_A(PG8_SA(0, 0), a2, 0, vg2);
            PG8_WAIT_V(8); PG8_WAIT_L(0); PG8_BAR; PG8_MMA(1, 0, At, B0); PG8_MMA(1, 1, At, B1); PG8_BAR; PG8_SCHED;
            PG8_LDB(B0, 1, 0); PG8_LDB(B1, 1, 1); PG8_SCHED; PG8_LDA(At, 1, 0); PG8_STAGE_A(PG8_SA(0, 1), a2, 1, vg2);
            PG8_WAIT_V(8); PG8_WAIT_L(0); PG8_BAR; PG8_MMA(0, 0, At, B0); PG8_MMA(0, 1, At, B1); PG8_BAR; PG8_SCHED;
            PG8_LDA(At, 1, 1); PG8_STAGE(PG8_SB(1, 0), b3, voffB); PG8_STAGE(PG8_SB(1, 1), b3 + hstep, voffB); PG8_STAGE_A(PG8_SA(1, 0), a3, 0, vg2);
            PG8_WAIT_V(8); PG8_WAIT_L(0); PG8_BAR; PG8_MMA(1, 0, At, B0); PG8_MMA(1, 1, At, B1); PG8_BAR; PG8_SCHED;
        }
        if (wr == 0) PG8_BAR;
        E(acc, cur, wr, wc, fr, fq);
        if (!has_next) break;
#pragma unroll
        for (int a = 0; a < 2; ++a)
#pragma unroll
            for (int b = 0; b < 2; ++b)
#pragma unroll
                for (int m = 0; m < 4; ++m)
#pragma unroll
                    for (int n = 0; n < 2; ++n) acc[a][b][m][n] = (f32x4){0.f, 0.f, 0.f, 0.f};
        cur = nxt; cA = nA; cB = nB; ++ui;
        if constexpr (GATHER) {
#pragma unroll
            for (int h = 0; h < 2; ++h)
#pragma unroll
                for (int i = 0; i < 2; ++i) vgc[h][i] = vgn[h][i];
        }
        if (wr == 1) PG8_BAR;
    }
    PG8_WAIT_V(0);
    PG8_BAR;
#undef PG8_SA
#undef PG8_SB
#undef PG8_STAGE
#undef PG8_STAGE_A
#undef PG8_LDA
#undef PG8_LDB
#undef PG8_MMA
#undef PG8_WAIT_V
#undef PG8_WAIT_L
#undef PG8_BAR
#undef PG8_SCHED
}
}

#define XB_TMO      128
#define XB_XCNT(j)  (256  + 64 * (j))
#define XB_XSUB(j)  (1280 + 64 * (j))
#define XB_XGEN(j)  (2304 + 64 * (j))
#define XB_TOP      3328
#define XB_TOPGEN   3392
#define XCD_BAR_WORDS 3456
#define XB_SPIN_CAP (1u << 18)
__device__ __forceinline__ unsigned xb_ld(unsigned* p)              { return __hip_atomic_load(p, __ATOMIC_RELAXED, __HIP_MEMORY_SCOPE_AGENT); }
__device__ __forceinline__ unsigned xb_add(unsigned* p, unsigned v) { return __hip_atomic_fetch_add(p, v, __ATOMIC_RELAXED, __HIP_MEMORY_SCOPE_AGENT); }
__device__ __forceinline__ unsigned xb_xcc_id() { return (unsigned)__builtin_amdgcn_s_getreg((3 << 11) | 20) & 0xFu; }
#define XB_SPIN(cond, bar) do { unsigned _sp = 0; while (cond) { __builtin_amdgcn_s_sleep(1); \
    if ((++_sp & 255u) == 0u) { if (xb_ld(&(bar)[XB_TMO])) break; if (_sp > XB_SPIN_CAP) { atomicAdd(&(bar)[XB_TMO], 1u); break; } } } } while (0)
struct XcdBarrier { unsigned* bar; unsigned x; volatile LAS unsigned* st; };
__device__ __forceinline__ XcdBarrier xcd_barrier_post(unsigned* bar, volatile LAS unsigned* st) {
    XcdBarrier b; b.bar = bar; b.x = xb_xcc_id(); b.st = st;
    if (threadIdx.x == 0) (void)xb_add(&bar[XB_XCNT(b.x)], 1u);
    return b;
}
__device__ __forceinline__ void xcd_barrier_complete(unsigned* bar, unsigned x, unsigned& nloc, unsigned& nx) {
    const unsigned G = gridDim.x * gridDim.y * gridDim.z;
    unsigned sum, cnt, mine, sp = 0u;
    for (;;) {
        sum = 0u; cnt = 0u; mine = 0u;
#pragma unroll
        for (unsigned j = 0; j < 16; ++j) { const unsigned c = xb_ld(&bar[XB_XCNT(j)]); sum += c; cnt += (c > 0u) ? 1u : 0u; mine = (j == x) ? c : mine; }
        if (sum == G) break;
        __builtin_amdgcn_s_sleep(1);
        if ((++sp & 255u) == 0u) { if (xb_ld(&bar[XB_TMO])) break; if (sp > XB_SPIN_CAP) { atomicAdd(&bar[XB_TMO], 1u); break; } }
    }
    nloc = mine > 0u ? mine : 1u; nx = cnt > 0u ? cnt : 1u;
}
__device__ __forceinline__ void xcd_barrier(const XcdBarrier& b, const bool leader) {
    asm volatile("s_waitcnt vmcnt(0)" ::: "memory");
    __syncthreads();
    if (leader) {
        unsigned* bar = b.bar; unsigned bx_ = b.x;
        asm volatile("" : "+s"(bar), "+s"(bx_));
        __builtin_amdgcn_s_waitcnt(0);
        unsigned nloc = b.st[0], nx = b.st[1];
        if (nloc == 0u) { xcd_barrier_complete(bar, bx_, nloc, nx); b.st[0] = nloc; b.st[1] = nx; }
        const unsigned old = xb_add(&bar[XB_XSUB(bx_)], 1u);
        const unsigned gen = old / nloc;
        if (old + 1u == (gen + 1u) * nloc) {
            __builtin_amdgcn_fence(__ATOMIC_RELEASE, "agent");
            asm volatile("s_waitcnt vmcnt(0)" ::: "memory");
            const unsigned og = xb_add(&bar[XB_TOP], 1u);
            const unsigned tg = og / nx;
            if (og + 1u == (tg + 1u) * nx) xb_add(&bar[XB_TOPGEN], 1u);
            else XB_SPIN(xb_ld(&bar[XB_TOPGEN]) == tg, bar);
            __builtin_amdgcn_fence(__ATOMIC_ACQUIRE, "agent");
            xb_add(&bar[XB_XGEN(bx_)], 1u);
            asm volatile("s_waitcnt vmcnt(0)" ::: "memory");
        } else {
            XB_SPIN(xb_ld(&bar[XB_XGEN(bx_)]) == gen, bar);
            __builtin_amdgcn_fence(__ATOMIC_ACQUIRE, "agent");
            asm volatile("s_waitcnt vmcnt(0)" ::: "memory");
        }
    }
    __syncthreads();
}

struct Args { const float* in[31]; float* out; unsigned char* ws; };
struct Frame {
    LAS unsigned char* lds;
    int tid, lane, wave, vcu, G, gw, NGW, bx;
    unsigned char* ws;
};

__device__ __forceinline__ void transpose_item64(const float* W, int ld, bf16_t* WT, int k0, int n0, int c0, int nvalid, int lane) {
    const float* src = W + (size_t)k0 * ld + c0 + lane; const bool ok = lane < nvalid;
    float v[64];
#pragma unroll
    for (int i = 0; i < 64; ++i) v[i] = ok ? src[(size_t)i * ld] : 0.f;
    u32x4* dst = (u32x4*)(WT + (size_t)(n0 + lane) * 1024 + k0);
#pragma unroll
    for (int j = 0; j < 8; ++j) { u32x4 o; o.x = pk2(v[8 * j], v[8 * j + 1]); o.y = pk2(v[8 * j + 2], v[8 * j + 3]); o.z = pk2(v[8 * j + 4], v[8 * j + 5]); o.w = pk2(v[8 * j + 6], v[8 * j + 7]); dst[j] = o; }
}
struct ConvJob { const float* w_in; int nin, npad; const float* w_out; const float* w_gu; const float* w_dn; size_t woff; };
__device__ __forceinline__ int conv_nitems(const ConvJob& J) { return 16 * (J.npad / 64) + 16 * 16 + NE * 16 * 32 + NE * 16 * 16; }
__device__ __forceinline__ void convert_item(const Frame& F, const ConvJob& J, int it) {
    bf16_t* WIN = (bf16_t*)(F.ws + J.woff + WS_WIN); bf16_t* WOUT = (bf16_t*)(F.ws + J.woff + WS_WOUT); bf16_t* WGU = (bf16_t*)(F.ws + J.woff + WS_WGU); bf16_t* WDN = (bf16_t*)(F.ws + J.woff + WS_WDN);
    const int I_IN = 16 * (J.npad / 64), I_OUT = 16 * 16, I_GU = NE * 16 * 32;
    const int lane = fresh_lane();
    int r = it;
    if (r < I_IN) { const int nblk = J.npad / 64, kb = r / nblk, nb = r % nblk; const int c0 = nb * 64; int nv = J.nin - c0; nv = nv < 0 ? 0 : (nv > 64 ? 64 : nv);
        transpose_item64(J.w_in, J.nin, WIN, kb * 64, nb * 64, c0, nv, lane); return; }
    r -= I_IN;
    if (r < I_OUT) { const int kb = r / 16, nb = r % 16; transpose_item64(J.w_out, D_, WOUT, kb * 64, nb * 64, nb * 64, 64, lane); return; }
    r -= I_OUT;
    if (r < I_GU) { const int e = r / (16 * 32), rr = r % (16 * 32), kb = rr / 32, nb = rr % 32; const int rho = nb * 64;
        const int pn = rho >> 8, bj = (rho >> 7) & 1, j = rho & 127; const int c0 = bj * DFF + pn * 128 + j;
        transpose_item64(J.w_gu + (size_t)e * D_ * 2 * DFF, 2 * DFF, WGU + (size_t)e * 2 * DFF * D_, kb * 64, rho, c0, 64, lane); return; }
    r -= I_GU;
    { const int e = r / (16 * 16), rr = r % (16 * 16), kb = rr / 16, nb = rr % 16;
        transpose_item64(J.w_dn + (size_t)e * DFF * D_, D_, WDN + (size_t)e * D_ * DFF, kb * 64, nb * 64, nb * 64, 64, lane); }
}
struct ConvAddr { const float* src; size_t ld; bf16_t* dst; bool ok; };
__device__ __forceinline__ ConvAddr conv_addr(const Frame& F, const ConvJob& J, int it, int lane) {
    bf16_t* WIN = (bf16_t*)(F.ws + J.woff + WS_WIN); bf16_t* WOUT = (bf16_t*)(F.ws + J.woff + WS_WOUT); bf16_t* WGU = (bf16_t*)(F.ws + J.woff + WS_WGU); bf16_t* WDN = (bf16_t*)(F.ws + J.woff + WS_WDN);
    const int I_IN = 16 * (J.npad / 64), I_OUT = 16 * 16, I_GU = NE * 16 * 32;
    ConvAddr a; int r = it;
    if (r < I_IN) { const int nblk = J.npad / 64, kb = r / nblk, nb = r % nblk; const int c0 = nb * 64; int nv = J.nin - c0; nv = nv < 0 ? 0 : (nv > 64 ? 64 : nv);
        a.src = J.w_in + (size_t)(kb * 64) * J.nin + c0 + lane; a.ld = J.nin; a.dst = WIN + (size_t)(nb * 64 + lane) * 1024 + kb * 64; a.ok = lane < nv; return a; }
    r -= I_IN;
    if (r < I_OUT) { const int kb = r / 16, nb = r % 16; a.src = J.w_out + (size_t)(kb * 64) * D_ + nb * 64 + lane; a.ld = D_; a.dst = WOUT + (size_t)(nb * 64 + lane) * 1024 + kb * 64; a.ok = true; return a; }
    r -= I_OUT;
    if (r < I_GU) { const int e = r / (16 * 32), rr = r % (16 * 32), kb = rr / 32, nb = rr % 32; const int rho = nb * 64;
        const int pn = rho >> 8, bj = (rho >> 7) & 1, j = rho & 127; const int c0 = bj * DFF + pn * 128 + j;
        a.src = J.w_gu + (size_t)e * D_ * 2 * DFF + (size_t)(kb * 64) * (2 * DFF) + c0 + lane; a.ld = 2 * DFF; a.dst = WGU + (size_t)e * 2 * DFF * D_ + (size_t)(rho + lane) * 1024 + kb * 64; a.ok = true; return a; }
    r -= I_GU;
    { const int e = r / (16 * 16), rr = r % (16 * 16), kb = rr / 16, nb = rr % 16;
      a.src = J.w_dn + (size_t)e * DFF * D_ + (size_t)(kb * 64) * D_ + nb * 64 + lane; a.ld = D_; a.dst = WDN + (size_t)e * D_ * DFF + (size_t)(nb * 64 + lane) * 1024 + kb * 64; a.ok = true; return a; }
}
__device__ __forceinline__ void conv_load(const ConvAddr& a, float (&v)[64]) {
#pragma unroll
    for (int i = 0; i < 64; ++i) v[i] = a.ok ? a.src[(size_t)i * a.ld] : 0.f;
}
__device__ __forceinline__ void conv_store(const ConvAddr& a, const float (&v)[64]) {
    u32x4* dst = (u32x4*)a.dst;
#pragma unroll
    for (int j = 0; j < 8; ++j) { u32x4 o; o.x = pk2(v[8 * j], v[8 * j + 1]); o.y = pk2(v[8 * j + 2], v[8 * j + 3]); o.z = pk2(v[8 * j + 4], v[8 * j + 5]); o.w = pk2(v[8 * j + 6], v[8 * j + 7]); dst[j] = o; }
}
__device__ __forceinline__ void convert_weights(const Frame& F, const ConvJob& J, int nfirst) {
    for (int it = F.gw; it < nfirst; it += F.NGW) convert_item(F, J, it);
}
__device__ __forceinline__ void convert_queue(const Frame& F, const ConvJob& J, int* ctr, int max_batches, const int per_wave = 1, const int item0 = 0) {
    volatile LAS int* word = (volatile LAS int*)(F.lds + MISC_OFF + 64);
    const int n = conv_nitems(J);
    for (int b = 0; b < max_batches; ++b) {
        __syncthreads();
        if (F.tid == 0) *word = atomicAdd(ctr, NWAVES * per_wave);
        __syncthreads();
        const int base = *word;
        if (item0 + base >= n) break;
        for (int k = 0; k < per_wave; ++k) { const int it = item0 + base + k * NWAVES + F.wave; if (it < n) convert_item(F, J, it); }
    }
    __syncthreads();
}
__device__ __forceinline__ void convert_x(const Frame& F, const float* x, bf16_t* xb) {
    for (int m = F.gw; m < NTOK; m += F.NGW) {
        const f32x4* xr = (const f32x4*)(x + (size_t)m * D_) + F.lane; u32x2* o = (u32x2*)(xb + (size_t)m * D_) + F.lane;
#pragma unroll
        for (int j = 0; j < 4; ++j) { const f32x4 v = xr[64 * j]; u32x2 w; w.x = pk2(v[0], v[1]); w.y = pk2(v[2], v[3]); o[64 * j] = w; }
    }
}

__device__ __forceinline__ float key2f(unsigned k) { return __uint_as_float((k & 0x80000000u) ? (k ^ 0x80000000u) : ~k); }
__device__ __forceinline__ unsigned f2key(float f) { unsigned b = __float_as_uint(f); return b ^ ((b >> 31) ? 0xFFFFFFFFu : 0x80000000u); }

__device__ __forceinline__ void conv_phase(const Frame& F, const bf16_t* H, const float* cw, bf16_t* Y) {
    for (int idx = (F.vcu * NTHR + F.tid); idx < NTOK * 64; idx += F.G * NTHR) {
        const int tok = idx >> 6, c = (idx & 63) * 8, t = tok & (S_ - 1);
        const bf16_t* h = H + (size_t)tok * EVEN_PAD;
        float y[8] = {0.f, 0.f, 0.f, 0.f, 0.f, 0.f, 0.f, 0.f};
#pragma unroll
        for (int j = 0; j < 3; ++j) if (t >= j) { const bf16_t* hj = h - (size_t)j * EVEN_PAD; const u32x4 gc = *(const u32x4*)(hj + E_GC + c), xa = *(const u32x4*)(hj + E_XA + c);
            const f32x4 w0 = *(const f32x4*)(cw + j * 512 + c), w1 = *(const f32x4*)(cw + j * 512 + c + 4);
            y[0] += w0[0] * (bflo(gc.x) * bflo(xa.x)); y[1] += w0[1] * (bfhi(gc.x) * bfhi(xa.x)); y[2] += w0[2] * (bflo(gc.y) * bflo(xa.y)); y[3] += w0[3] * (bfhi(gc.y) * bfhi(xa.y));
            y[4] += w1[0] * (bflo(gc.z) * bflo(xa.z)); y[5] += w1[1] * (bfhi(gc.z) * bfhi(xa.z)); y[6] += w1[2] * (bflo(gc.w) * bflo(xa.w)); y[7] += w1[3] * (bfhi(gc.w) * bfhi(xa.w)); }
        const u32x4 gb = *(const u32x4*)(h + E_GB + c);
        u32x4 o; o.x = pk2(bflo(gb.x) * y[0], bfhi(gb.x) * y[1]); o.y = pk2(bflo(gb.y) * y[2], bfhi(gb.y) * y[3]); o.z = pk2(bflo(gb.z) * y[4], bfhi(gb.z) * y[5]); o.w = pk2(bflo(gb.w) * y[6], bfhi(gb.w) * y[7]);
        *(u32x4*)(Y + (size_t)tok * D_ + c) = o;
    }
}

__device__ __forceinline__ void dsa_select_phase(const Frame& F, const bf16_t* H, unsigned long long* MASK, const ConvJob& CJ, int* cctr, const int citem0) {
    typedef float f32x16 __attribute__((ext_vector_type(16)));
    LAS float* sc = (LAS float*)F.lds;
    const int lane = F.lane, wid = F.wave, c = lane & 31, hi = lane >> 5;
    const int rho = lane & 31, ah = (rho & 3) + 4 * ((rho >> 3) & 1), at = ((rho >> 2) & 1) + 2 * (rho >> 4);
    int cbase1 = -1;
    for (int itp = F.vcu; itp < 1024; itp += F.G) {
        const int bb = itp >> 8, vv = itp & 255;
        for (int pp = 0; pp < 2; ++pp) {
            const int p = pp ? 511 - vv : vv;
            const int tq0 = 8 * p, tmax = tq0 + 7, ntile = (tmax >> 5) + 1;
            if (F.tid == 0) *(volatile LAS int*)(F.lds + MISC_OFF + 64) = atomicAdd(cctr, 2 * NWAVES);
            const size_t row0 = (size_t)bb * S_ + tq0;
            bf16x8 af[2][2]; float wq[2][16];
#pragma unroll
            for (int g = 0; g < 2; ++g) {
                const bf16_t* qrow = H + (row0 + 4 * g + at) * EVEN_PAD + E_IQ + ah * 32 + 8 * hi;
                af[g][0] = *(const bf16x8*)qrow; af[g][1] = *(const bf16x8*)(qrow + 16);
#pragma unroll
                for (int q2 = 0; q2 < 2; ++q2) { const u32x4 w = *(const u32x4*)(H + (row0 + 4 * g + hi + 2 * q2) * EVEN_PAD + E_IW);
                    wq[g][8 * q2 + 0] = bflo(w.x); wq[g][8 * q2 + 1] = bfhi(w.x); wq[g][8 * q2 + 2] = bflo(w.y); wq[g][8 * q2 + 3] = bfhi(w.y);
                    wq[g][8 * q2 + 4] = bflo(w.z); wq[g][8 * q2 + 5] = bfhi(w.z); wq[g][8 * q2 + 6] = bflo(w.w); wq[g][8 * q2 + 7] = bfhi(w.w); }
            }
#define SEL_LOAD(BQ, tb_) do { _Pragma("unroll") for (int q4 = 0; q4 < 4; ++q4) { int tile = (tb_) + q4 * NWAVES; tile = tile < ntile ? tile : ntile - 1; \
                    const bf16_t* krow = H + ((size_t)bb * S_ + 32 * tile + c) * EVEN_PAD + E_IK + 8 * hi; \
                    BQ[q4][0] = *(const bf16x8*)krow; BQ[q4][1] = *(const bf16x8*)(krow + 16); } } while (0)
#define SEL_COMP(BQ, tb_) do { _Pragma("unroll") for (int q4 = 0; q4 < 4; ++q4) { const int tile = (tb_) + q4 * NWAVES; \
                    if (tile < ntile) { const int key = 32 * tile + c; \
                        _Pragma("unroll") for (int g = 0; g < 2; ++g) { \
                            f32x16 d = {0.f, 0.f, 0.f, 0.f, 0.f, 0.f, 0.f, 0.f, 0.f, 0.f, 0.f, 0.f, 0.f, 0.f, 0.f, 0.f}; \
                            d = __builtin_amdgcn_mfma_f32_32x32x16_bf16(af[g][0], BQ[q4][0], d, 0, 0, 0); \
                            d = __builtin_amdgcn_mfma_f32_32x32x16_bf16(af[g][1], BQ[q4][1], d, 0, 0, 0); \
                            float s0 = 0.f, s1 = 0.f; \
                            _Pragma("unroll") for (int r = 0; r < 8; ++r) { s0 += wq[g][r] * fmaxf(d[r], 0.f); s1 += wq[g][8 + r] * fmaxf(d[8 + r], 0.f); } \
                            sc[(4 * g + hi) * S_ + key] = s0; sc[(4 * g + hi + 2) * S_ + key] = s1; } } } } while (0)
            {
                const int cit1 = cbase1 >= 0 ? citem0 + cbase1 + NWAVES + wid : 0x7fffffff; const bool chas1 = cit1 < conv_nitems(CJ);
                ConvAddr ca1; float cv1[64];
                if (chas1) { ca1 = conv_addr(F, CJ, cit1, fresh_lane()); conv_load(ca1, cv1); }
                bf16x8 bqA[4][2];
                for (int tb = wid; tb < ntile; tb += 4 * NWAVES) { SEL_LOAD(bqA, tb); SEL_COMP(bqA, tb); }
                if (chas1) conv_store(ca1, cv1);
            }
#undef SEL_LOAD
#undef SEL_COMP
            __syncthreads();
            {
                const int lane2 = fresh_lane();
                const int t = tq0 + wid, n = t + 1;
                cbase1 = *(volatile LAS int*)(F.lds + MISC_OFF + 64);
                const int cit = citem0 + cbase1 + wid; const bool chas = cit < conv_nitems(CJ);
                ConvAddr ca; float cv[64];
                if (chas) { ca = conv_addr(F, CJ, cit, lane2); conv_load(ca, cv); }
                unsigned long long myword = 0ull;
                if (n <= 256) {
                    const int k0 = 64 * lane2;
                    myword = (k0 + 63 <= t) ? ~0ull : (k0 > t) ? 0ull : ((1ull << (t - k0 + 1)) - 1ull);
                } else {
                    const LAS float* scr = sc + wid * S_;
                    float u[64];
                    const int nreg = (n + 63) >> 6, nfull = n >> 6;
#pragma unroll
                    for (int ch = 0; ch < 4; ++ch) {
                        if (nfull >= 16 * ch + 16) {
#pragma unroll
                            for (int i = 16 * ch; i < 16 * ch + 16; ++i) u[i] = scr[64 * i + lane2];
                        } else if (nreg > 16 * ch) {
#pragma unroll
                            for (int i = 16 * ch; i < 16 * ch + 16; ++i) { const int s_ = 64 * i + lane2; const float v = scr[s_]; u[i] = (s_ <= t) ? v : -INFINITY; }
                        } else {
#pragma unroll
                            for (int i = 16 * ch; i < 16 * ch + 16; ++i) u[i] = -INFINITY;
                        }
                    }
                    unsigned T = 0u; bool exact = false;
#pragma unroll 1
                    for (int bit = 31; bit >= 0; --bit) {
                        const unsigned candk = T | (1u << bit); const float cand = key2f(candk); int c0_ = 0, c1_ = 0, c2_ = 0, c3_ = 0;
#pragma unroll
                        for (int ch = 0; ch < 4; ++ch) if (nreg > 16 * ch) {
#pragma unroll
                            for (int i = 0; i < 16; i += 4) { c0_ += (u[16 * ch + i] >= cand) ? 1 : 0; c1_ += (u[16 * ch + i + 1] >= cand) ? 1 : 0; c2_ += (u[16 * ch + i + 2] >= cand) ? 1 : 0; c3_ += (u[16 * ch + i + 3] >= cand) ? 1 : 0; } }
                        const int cl = wave_sum_iu((c0_ + c1_) + (c2_ + c3_));
                        if (cl >= 256) T = candk;
                        if (cl == 256) { exact = true; break; }
                    }
                    if (exact) {
                        float T3; { int tv = (int)T; asm volatile("" : "+v"(tv)); T3 = key2f((unsigned)__builtin_amdgcn_readfirstlane(tv)); }
#pragma unroll
                        for (int ch = 0; ch < 4; ++ch) if (nreg > 16 * ch) {
#pragma unroll
                            for (int i = 16 * ch; i < 16 * ch + 16; ++i) { const unsigned long long w = __ballot(u[i] >= T3); if (lane2 == i) myword = w; if ((i & 3) == 3) __builtin_amdgcn_sched_barrier(0); } }
                    } else {
                    int ngt = 0;
                    const float Tf = key2f(T);
#pragma unroll
                    for (int i = 0; i < 64; ++i) { ngt += __popcll(__ballot(u[i] > Tf)); if ((i & 3) == 3) __builtin_amdgcn_sched_barrier(0); }
                    int need = 256 - ngt;
                    float T2; { int tv = (int)T; asm volatile("" : "+v"(tv)); T2 = key2f((unsigned)__builtin_amdgcn_readfirstlane(tv)); }
                    int base = 0;
#pragma unroll
                    for (int i = 0; i < 64; ++i) {
                        const bool gtb = u[i] > T2, eqb = u[i] == T2;
                        const unsigned long long eq = __ballot(eqb);
                        const int rk = base + (int)__builtin_amdgcn_mbcnt_hi((unsigned)(eq >> 32), __builtin_amdgcn_mbcnt_lo((unsigned)eq, 0u));
                        const unsigned long long w = __ballot(gtb || (eqb && rk < need));
                        base += __popcll(eq);
                        if (lane2 == i) myword = w;
                        __builtin_amdgcn_sched_barrier(0);
                    }
                    }
                }
                MASK[(row0 + wid) * 64 + lane2] = myword;
                if (chas) conv_store(ca, cv);
            }
            __syncthreads();
        }
    }
    if (cbase1 >= 0) { const int citl = citem0 + cbase1 + NWAVES + wid; if (citl < conv_nitems(CJ)) convert_item(F, CJ, citl); }
}

namespace att {
typedef float f32x16 __attribute__((ext_vector_type(16)));
typedef short s16x4 __attribute__((ext_vector_type(4)));
constexpr int NW = 8, QBLK = 32, QB = 256, KVBLK = 64;
constexpr float C2 = 0.125f * 1.4426950408889634f;
constexpr float LOG2E = 1.4426950408889634f;
constexpr int SLOTB = 8192, LDS_K = 0, LDS_V = 3 * SLOTB, LDS_WS = 6 * SLOTB, LDS_OST = LDS_WS + NW * 256, LDS_ATT_BYTES = LDS_OST + NW * 4096;
constexpr int THR = 8;
#define SBAR() __builtin_amdgcn_sched_barrier(0)
#define PIN(x) asm volatile("" : "+v"(x))
#define MFMA(a, b, c) __builtin_amdgcn_mfma_f32_32x32x16_bf16(a, b, c, 0, 0, 0)
#define WAIT_BAR(N) asm volatile("s_waitcnt vmcnt(" #N ") lgkmcnt(0)\n\ts_barrier" ::: "memory")
__device__ __forceinline__ int crow(int r, int hi) { return (r & 3) + 8 * (r >> 2) + 4 * hi; }
__device__ __forceinline__ unsigned cvtpk(float lo, float hi) { unsigned r; asm("v_cvt_pk_bf16_f32 %0, %1, %2" : "=v"(r) : "v"(lo), "v"(hi)); return r; }
__device__ __forceinline__ void glds16(const void* g, unsigned lds_base) {
    unsigned sv; asm volatile("s_mov_b32 %0, m0\n\ts_mov_b32 m0, %2\n\ts_nop 0\n\tglobal_load_lds_dwordx4 %1, off\n\ts_mov_b32 m0, %0" : "=&s"(sv) : "v"(g), "s"(lds_base) : "memory"); }
typedef __attribute__((address_space(3))) const char* lds_cptr;
typedef short v4i16_t __attribute__((ext_vector_type(4)));
__device__ __forceinline__ void kload2(bf16x8* kf, lds_cptr kp, int d0) { kf[2 * d0] = *(const __attribute__((address_space(3))) bf16x8*)(kp + d0 * 2048); kf[2 * d0 + 1] = *(const __attribute__((address_space(3))) bf16x8*)(kp + d0 * 2048 + 512); }
__device__ __forceinline__ s16x4 vtr(lds_cptr p) { return __builtin_bit_cast(s16x4, __builtin_amdgcn_ds_read_tr16_b64_v4i16((__attribute__((address_space(3))) v4i16_t*)p)); }
#define MX3(a, b, c) __builtin_fmaxf(__builtin_fmaxf((a), (b)), (c))
__device__ __forceinline__ float max16(const f32x16& p) {
    float a = MX3(p[0], p[1], p[2]), b = MX3(p[3], p[4], p[5]); a = MX3(a, p[6], p[7]); b = MX3(b, p[8], p[9]); a = MX3(a, p[10], p[11]); b = MX3(b, p[12], p[13]); a = MX3(a, p[14], p[15]);
    return __builtin_fmaxf(a, b); }
__device__ __forceinline__ float halfmax(float m) { auto rr = __builtin_amdgcn_permlane32_swap(__float_as_uint(m), __float_as_uint(m), false, false); return __builtin_fmaxf(__uint_as_float(rr[0]), __uint_as_float(rr[1])); }
__device__ __forceinline__ void cmask(f32x16& p0, f32x16& p1, int jb, int qrel, int hi) {
    const int kb = 64 * jb + 4 * hi;
#pragma unroll
    for (int r = 0; r < 16; ++r) { const int kv = kb + (r & 3) + 8 * (r >> 2); if (kv > qrel) p0[r] = -INFINITY; if (kv + 32 > qrel) p1[r] = -INFINITY; } }
__device__ __forceinline__ void wmask(f32x16& p0, f32x16& p1, unsigned lo, unsigned hw, int hi) {
    lo >>= 4 * hi; hw >>= 4 * hi;
#pragma unroll
    for (int r = 0; r < 16; ++r) { const int cr = (r & 3) + 8 * (r >> 2);
        const unsigned m0 = (unsigned)((int)(lo << (31 - cr)) >> 31), m1 = (unsigned)((int)(hw << (31 - cr)) >> 31);
        p0[r] = __uint_as_float((__float_as_uint(p0[r]) & m0) | (0xff800000u & ~m0)); p1[r] = __uint_as_float((__float_as_uint(p1[r]) & m1) | (0xff800000u & ~m1)); } }

template <int MODE>
__device__ __forceinline__ void attn_unit(const bf16_t* Qh, const bf16_t* Kh, const bf16_t* Vh, bf16_t* Oh, const int QP, const int KP, const int VP, const int OP,
                                          const int rowbase, const int qb, const float sl2, const unsigned long long* maskp, char* lds, const int tid) {
    const int lane = tid & 63, r32 = lane & 31, hi = lane >> 5; const int wid = __builtin_amdgcn_readfirstlane(tid >> 6);
    const int q0 = qb * QB, NT = (q0 + QB) / KVBLK;
    const bf16_t* Qw = Qh + (size_t)(rowbase + q0 + wid * QBLK) * QP;
    const unsigned lds0 = (unsigned)(uintptr_t)lds; float* wsf = (float*)(lds + LDS_WS) + wid * 64;
    const bf16_t* ksrc = Kh + (size_t)rowbase * KP + (size_t)lane * KP + wid * 8;
    const bf16_t* vsrc = Vh + (size_t)rowbase * VP + (size_t)(16 * (wid & 3) + (lane >> 2)) * VP + (wid >> 2) * 32 + (lane & 3) * 8;
    const unsigned kdst = lds0 + LDS_K + wid * 1024, vdst = lds0 + LDS_V + wid * 1024;
#define DMA_K(t, slot) glds16(ksrc + (size_t)(NT - 1 - (t)) * KVBLK * KP, (unsigned)__builtin_amdgcn_readfirstlane(kdst + (slot)))
#define DMA_V(t, slot) glds16(vsrc + (size_t)(NT - 1 - (t)) * KVBLK * VP, (unsigned)__builtin_amdgcn_readfirstlane(vdst + (slot)))
    const lds_cptr vp0 = (lds_cptr)lds + LDS_V + ((lane >> 4) & 1) * 32 + (lane & 3) * 8 + (4 * hi + ((lane & 15) >> 2)) * 64;
    const lds_cptr kp0 = (lds_cptr)lds + LDS_K + hi * 1024 + r32 * 16;
    DMA_K(0, 0); DMA_V(0, 0); DMA_K(1, SLOTB);
    bf16x8 qr[4];
#pragma unroll
    for (int d0 = 0; d0 < 4; ++d0) qr[d0] = *reinterpret_cast<const bf16x8*>(&Qw[(size_t)r32 * QP + d0 * 16 + hi * 8]);
    const int qrel = wid * QBLK + r32;
    const unsigned moff = (unsigned)qrel * 512u;
    unsigned long long mw = 0ull;
    if (MODE == 1) mw = *(const unsigned long long*)((const char*)maskp + (moff + 8u * (unsigned)(NT - 1)));
    float mhat = 0.f, l_reg = 0.f; f32x16 o[2]; o[0] = f32x16{}; o[1] = f32x16{};
    f32x16 bz;
#pragma unroll
    for (int r = 0; r < 16; ++r) bz[r] = sl2 * (float)((r & 3) + 8 * (r >> 2) + 4 * hi - 255) * (1.0f / C2);
    PIN(bz);
    bool resc = false;
    f32x16 pA0, pA1, pB0, pB1; bf16x8 kf[8]; s16x4 vlo[8], vhi[8]; u32x4 pw0, pw1, pw2, pw3;
    int sl_prev = 0, sl_cur = 0, sl_next = SLOTB;
#define ROT() do { sl_prev = sl_cur; sl_cur = sl_next; sl_next = (sl_next == 2 * SLOTB) ? 0 : sl_next + SLOTB; } while (0)
#define EX0(v) __builtin_amdgcn_exp2f(__builtin_fmaf((v), C2, nmh0))
#define EX1(v) __builtin_amdgcn_exp2f(__builtin_fmaf((v), C2, nmh1))
#define BT0(t) (sl2 * (float)(64 * (3 - (t))))
#define RESC() do { if (resc) { _Pragma("unroll") for (int d_ = 0; d_ < 2; ++d_) _Pragma("unroll") for (int r = 0; r < 16; ++r) o[d_][r] *= wsf[crow(r, hi)]; } } while (0)
    DMA_K(2, 2 * SLOTB);
    WAIT_BAR(3);
    _Pragma("unroll") for (int d0 = 0; d0 < 4; ++d0) kload2(kf, kp0, d0);
    pA0 = MFMA(kf[0], qr[0], bz); pA1 = MFMA(kf[1], qr[0], bz); pA0 = MFMA(kf[2], qr[1], pA0); pA1 = MFMA(kf[3], qr[1], pA1);
    pA0 = MFMA(kf[4], qr[2], pA0); pA1 = MFMA(kf[5], qr[2], pA1); pA0 = MFMA(kf[6], qr[3], pA0); pA1 = MFMA(kf[7], qr[3], pA1);
    if (MODE == 0) cmask(pA0, pA1, 3, qrel, hi); else wmask(pA0, pA1, (unsigned)mw, (unsigned)(mw >> 32), hi);
    { const float b0 = BT0(0), b1 = b0 + 32.f * sl2;
      const float rm = halfmax(__builtin_fmaxf(__builtin_fmaf(max16(pA0), C2, b0), __builtin_fmaf(max16(pA1), C2, b1)));
      mhat = __builtin_fmaxf(rm, -1e30f); const float nmh0 = b0 - mhat, nmh1 = b1 - mhat;
#pragma unroll
      for (int r = 0; r < 16; ++r) { pA0[r] = EX0(pA0[r]); pA1[r] = EX1(pA1[r]); } }
    WAIT_BAR(0);
    DMA_K(3, 0); DMA_V(1, SLOTB); ROT();
    _Pragma("unroll") for (int d0 = 0; d0 < 4; ++d0) kload2(kf, kp0 + sl_cur, d0);
    WAIT_BAR(2);
#define PKW(P, i) cvtpk(P[i], P[i + 1])
#define PAF(k) __builtin_bit_cast(bf16x8, pw##k)
#define VFR(i) (bf16x8){vlo[i][0], vlo[i][1], vlo[i][2], vlo[i][3], vhi[i][0], vhi[i][1], vhi[i][2], vhi[i][3]}
#define VRD(i) do { vlo[i] = vtr(vp_ + (((i) >> 2) * 4096 + ((i) & 3) * 1024)); vhi[i] = vtr(vp_ + (((i) >> 2) * 4096 + ((i) & 3) * 1024 + 512)); } while (0)
#define KRD(G, d0) do { if (G) { kload2(kf, kp0 + sl_next, d0); SBAR(); } } while (0)
#define GAPA(MF, a0, a1, a2, a3, W0, W1, PW) do { MF; sacc += a0; sacc += a1; sacc += a2; sacc += a3; W0; W1; PIN(PW); PIN(sacc); SBAR(); } while (0)
#define GAPB0(MF, X, i) do { MF; X[i] = EX0(X[i]); X[i + 1] = EX0(X[i + 1]); X[i + 2] = EX0(X[i + 2]); X[i + 3] = EX0(X[i + 3]); PIN(X); SBAR(); } while (0)
#define GAPB1(MF, X, i) do { MF; X[i] = EX1(X[i]); X[i + 1] = EX1(X[i + 1]); X[i + 2] = EX1(X[i + 2]); X[i + 3] = EX1(X[i + 3]); PIN(X); SBAR(); } while (0)
#define STEP(C0, C1, P0, P1, t, MASK, GK, GV, GL) do { SBAR(); \
    const lds_cptr vp_ = vp0 + sl_prev; \
    if (MODE == 1) mw = *(const unsigned long long*)((const char*)maskp + (moff + 8u * (unsigned)(NT - 1 - (t)))); \
    VRD(0); SBAR(); float sacc = P0[0] + P0[1]; \
                    GAPA(C0 = MFMA(kf[0], qr[0], bz), P0[2], P0[3], P0[4], P0[5],     pw0[0] = PKW(P0, 0),  pw0[1] = PKW(P0, 2),  pw0); \
    VRD(4); SBAR(); GAPA(C1 = MFMA(kf[1], qr[0], bz), P0[6], P0[7], P0[8], P0[9],     pw0[2] = PKW(P0, 4),  pw0[3] = PKW(P0, 6),  pw0); \
    VRD(1); SBAR(); GAPA(C0 = MFMA(kf[2], qr[1], C0),    P0[10], P0[11], P0[12], P0[13], pw1[0] = PKW(P0, 8),  pw1[1] = PKW(P0, 10), pw1); \
    VRD(5); SBAR(); GAPA(C1 = MFMA(kf[3], qr[1], C1),    P0[14], P0[15], P1[0], P1[1],   pw1[2] = PKW(P0, 12), pw1[3] = PKW(P0, 14), pw1); \
    VRD(2); SBAR(); GAPA(C0 = MFMA(kf[4], qr[2], C0),    P1[2], P1[3], P1[4], P1[5],     pw2[0] = PKW(P1, 0),  pw2[1] = PKW(P1, 2),  pw2); \
    VRD(6); SBAR(); GAPA(C1 = MFMA(kf[5], qr[2], C1),    P1[6], P1[7], P1[8], P1[9],     pw2[2] = PKW(P1, 4),  pw2[3] = PKW(P1, 6),  pw2); \
    VRD(3); SBAR(); GAPA(C0 = MFMA(kf[6], qr[3], C0),    P1[10], P1[11], P1[12], P1[13], pw3[0] = PKW(P1, 8),  pw3[1] = PKW(P1, 10), pw3); \
    VRD(7); SBAR(); GAPA(C1 = MFMA(kf[7], qr[3], C1),    P1[14], P1[15], 0.f, 0.f,       pw3[2] = PKW(P1, 12), pw3[3] = PKW(P1, 14), pw3); \
    l_reg += sacc; \
    if (MODE == 1) wmask(C0, C1, (unsigned)mw, (unsigned)(mw >> 32), hi); \
    if (GK) DMA_K((t) + 3, sl_cur); if (GV) DMA_V((t) + 1, sl_next); \
    if (MODE == 0) { if (MASK) cmask(C0, C1, 3 - (t), qrel, hi); } \
    const float b0_ = BT0(t), b1_ = b0_ + 32.f * sl2; \
    { const float rma = halfmax(__builtin_fmaxf(__builtin_fmaf(max16(C0), C2, b0_), __builtin_fmaf(max16(C1), C2, b1_))); resc = false;     \
      if (__builtin_expect(__any(rma - mhat > (float)THR), 0)) { const float mn_ = __builtin_fmaxf(mhat, rma); \
          const float f = __builtin_amdgcn_exp2f(mhat - mn_); mhat = mn_; l_reg *= f; if (hi == 0) wsf[r32] = f; resc = true; } } \
    const float nmh0 = b0_ - mhat, nmh1 = b1_ - mhat; SBAR(); \
    GAPB0(o[0] = MFMA(PAF(0), VFR(0), o[0]), C0, 0);              GAPB0(o[1] = MFMA(PAF(0), VFR(4), o[1]), C0, 4); \
    KRD(GL, 0); GAPB0(o[0] = MFMA(PAF(1), VFR(1), o[0]), C0, 8);  KRD(GL, 1); GAPB0(o[1] = MFMA(PAF(1), VFR(5), o[1]), C0, 12); \
    KRD(GL, 2); GAPB1(o[0] = MFMA(PAF(2), VFR(2), o[0]), C1, 0);  KRD(GL, 3); GAPB1(o[1] = MFMA(PAF(2), VFR(6), o[1]), C1, 4); \
    GAPB1(o[0] = MFMA(PAF(3), VFR(3), o[0]), C1, 8);              GAPB1(o[1] = MFMA(PAF(3), VFR(7), o[1]), C1, 12); \
    } while (0)
#define ENDW(tt) do { if ((tt) + 3 < NT) { WAIT_BAR(2); } else if ((tt) + 2 < NT) { WAIT_BAR(1); } else { WAIT_BAR(0); } } while (0)
    int t = 1;
    for (; t <= 3 && t + 1 < NT; t += 2) {
        STEP(pB0, pB1, pA0, pA1, t, (t <= 3), (t + 3 < NT), (t + 1 < NT), (t + 1 < NT));             ENDW(t);     RESC(); ROT();
        STEP(pA0, pA1, pB0, pB1, t + 1, (t + 1 <= 3), (t + 4 < NT), (t + 2 < NT), (t + 2 < NT));     ENDW(t + 1); RESC(); ROT();
    }
    for (; t + 5 < NT; t += 2) {
        STEP(pB0, pB1, pA0, pA1, t, false, true, true, true);     WAIT_BAR(2); RESC(); ROT();
        STEP(pA0, pA1, pB0, pB1, t + 1, false, true, true, true); WAIT_BAR(2); RESC(); ROT();
    }
    for (; t + 1 < NT; t += 2) {
        STEP(pB0, pB1, pA0, pA1, t, (t <= 3), (t + 3 < NT), (t + 1 < NT), (t + 1 < NT));             ENDW(t);     RESC(); ROT();
        STEP(pA0, pA1, pB0, pB1, t + 1, (t + 1 <= 3), (t + 4 < NT), (t + 2 < NT), (t + 2 < NT));     ENDW(t + 1); RESC(); ROT();
    }
    STEP(pB0, pB1, pA0, pA1, NT - 1, (NT - 1 <= 3), false, false, false); RESC();
    { float sacc = pB0[0] + pB0[1];
#pragma unroll
      for (int r = 2; r < 16; ++r) sacc += pB0[r];
#pragma unroll
      for (int r = 0; r < 16; ++r) sacc += pB1[r];
      l_reg += sacc;
      pw0 = (u32x4){PKW(pB0, 0), PKW(pB0, 2), PKW(pB0, 4), PKW(pB0, 6)}; pw1 = (u32x4){PKW(pB0, 8), PKW(pB0, 10), PKW(pB0, 12), PKW(pB0, 14)};
      pw2 = (u32x4){PKW(pB1, 0), PKW(pB1, 2), PKW(pB1, 4), PKW(pB1, 6)}; pw3 = (u32x4){PKW(pB1, 8), PKW(pB1, 10), PKW(pB1, 12), PKW(pB1, 14)};
      const lds_cptr vp_ = vp0 + sl_cur; _Pragma("unroll") for (int i = 0; i < 8; ++i) VRD(i);
      o[0] = MFMA(PAF(0), VFR(0), o[0]); o[1] = MFMA(PAF(0), VFR(4), o[1]); o[0] = MFMA(PAF(1), VFR(1), o[0]); o[1] = MFMA(PAF(1), VFR(5), o[1]);
      o[0] = MFMA(PAF(2), VFR(2), o[0]); o[1] = MFMA(PAF(2), VFR(6), o[1]); o[0] = MFMA(PAF(3), VFR(3), o[0]); o[1] = MFMA(PAF(3), VFR(7), o[1]); }
    { auto rr = __builtin_amdgcn_permlane32_swap(__float_as_uint(l_reg), __float_as_uint(l_reg), false, false); l_reg = __uint_as_float(rr[0]) + __uint_as_float(rr[1]); }
    if (hi == 0) wsf[32 + r32] = l_reg; asm volatile("s_waitcnt lgkmcnt(0)" ::: "memory");
    float rli[16];
#pragma unroll
    for (int r = 0; r < 16; ++r) rli[r] = __builtin_amdgcn_rcpf(wsf[32 + crow(r, hi)]);
    bf16_t* Ow = Oh + (size_t)(rowbase + q0 + wid * QBLK) * OP; bf16_t* stg = (bf16_t*)(lds + LDS_OST) + wid * 2048;
#pragma unroll
    for (int r = 0; r < 16; ++r) { const int orow = crow(r, hi);
#pragma unroll
        for (int d0 = 0; d0 < 2; ++d0) stg[orow * 64 + d0 * 32 + r32] = (bf16_t)f2bf(o[d0][r] * rli[r]); }
    asm volatile("s_waitcnt lgkmcnt(0)" ::: "memory");
#pragma unroll
    for (int i = 0; i < 4; ++i) { const int row = i * 8 + (lane >> 3), ch = lane & 7; *(u32x4*)(Ow + (size_t)row * OP + ch * 8) = *(const u32x4*)(stg + row * 64 + ch * 8); }
    asm volatile("s_waitcnt lgkmcnt(0)\n\ts_barrier" ::: "memory");
#undef DMA_K
#undef DMA_V
#undef ROT
#undef EX0
#undef EX1
#undef BT0
#undef RESC
#undef PKW
#undef PAF
#undef VFR
#undef VRD
#undef KRD
#undef ENDW
#undef GAPA
#undef GAPB0
#undef GAPB1
#undef STEP
}
__device__ __forceinline__ void attn_unit_w(const bf16_t* Qh, const bf16_t* Kh, const bf16_t* Vh, bf16_t* Oh, const int QP, const int KP, const int VP, const int OP,
                                          const int rowbase, const int qb, const float sl2, const unsigned long long* maskp, char* lds, const int tid) {
    constexpr int MODE = 0; constexpr int L_WS = LDS_V + 6 * SLOTB;
    const int lane = tid & 63, r32 = lane & 31, hi = lane >> 5; const int wid = __builtin_amdgcn_readfirstlane(tid >> 6);
    const int q0 = qb * QB, NT = (q0 + QB) / KVBLK;
    const bf16_t* Qw = Qh + (size_t)(rowbase + q0 + wid * QBLK) * QP;
    const unsigned lds0 = (unsigned)(uintptr_t)lds; float* wsf = (float*)(lds + L_WS) + wid * 64;
    const bf16_t* ksrc = Kh + (size_t)rowbase * KP + (size_t)lane * KP + wid * 8;
    const bf16_t* vsrc = Vh + (size_t)rowbase * VP + (size_t)(16 * (wid & 3) + (lane >> 2)) * VP + (wid >> 2) * 32 + (lane & 3) * 8;
    const unsigned kdst = lds0 + LDS_K + wid * 1024, vdst = lds0 + LDS_V + wid * 1024;
#define DMA_K(t, slot) glds16(ksrc + (size_t)(NT - 1 - (t)) * KVBLK * KP, (unsigned)__builtin_amdgcn_readfirstlane(kdst + (slot)))
#define DMA_V(t, slot) do { glds16(vsrc + (size_t)(NT - 1 - (t)) * KVBLK * VP, (unsigned)__builtin_amdgcn_readfirstlane(vdst + 2 * (slot))); \
        glds16(vsrc + 64 + (size_t)(NT - 1 - (t)) * KVBLK * VP, (unsigned)__builtin_amdgcn_readfirstlane(vdst + 2 * (slot) + 8192)); } while (0)
    const lds_cptr vp0 = (lds_cptr)lds + LDS_V + ((lane >> 4) & 1) * 32 + (lane & 3) * 8 + (4 * hi + ((lane & 15) >> 2)) * 64;
    const lds_cptr kp0 = (lds_cptr)lds + LDS_K + hi * 1024 + r32 * 16;
    DMA_K(0, 0); DMA_V(0, 0); DMA_K(1, SLOTB);
    bf16x8 qr[4];
#pragma unroll
    for (int d0 = 0; d0 < 4; ++d0) qr[d0] = *reinterpret_cast<const bf16x8*>(&Qw[(size_t)r32 * QP + d0 * 16 + hi * 8]);
    const int qrel = wid * QBLK + r32;
    const unsigned moff = (unsigned)qrel * 512u;
    unsigned long long mw = 0ull;
    if (MODE == 1) mw = *(const unsigned long long*)((const char*)maskp + (moff + 8u * (unsigned)(NT - 1)));
    float mhat = 0.f, l_reg = 0.f; f32x16 o[4]; o[0] = f32x16{}; o[1] = f32x16{}; o[2] = f32x16{}; o[3] = f32x16{};
    f32x16 bz;
#pragma unroll
    for (int r = 0; r < 16; ++r) bz[r] = sl2 * (float)((r & 3) + 8 * (r >> 2) + 4 * hi - 255) * (1.0f / C2);
    PIN(bz);
    bool resc = false;
    f32x16 pA0, pA1, pB0, pB1; bf16x8 kf[8]; s16x4 vlo[8], vhi[8]; u32x4 pw0, pw1, pw2, pw3;
    int sl_prev = 0, sl_cur = 0, sl_next = SLOTB;
#define ROT() do { sl_prev = sl_cur; sl_cur = sl_next; sl_next = (sl_next == 2 * SLOTB) ? 0 : sl_next + SLOTB; } while (0)
#define EX0(v) __builtin_amdgcn_exp2f(__builtin_fmaf((v), C2, nmh0))
#define EX1(v) __builtin_amdgcn_exp2f(__builtin_fmaf((v), C2, nmh1))
#define BT0(t) (sl2 * (float)(64 * (3 - (t))))
#define RESC() do { if (resc) { _Pragma("unroll") for (int d_ = 0; d_ < 4; ++d_) _Pragma("unroll") for (int r = 0; r < 16; ++r) o[d_][r] *= wsf[crow(r, hi)]; } } while (0)
    DMA_K(2, 2 * SLOTB);
    WAIT_BAR(3);
    _Pragma("unroll") for (int d0 = 0; d0 < 4; ++d0) kload2(kf, kp0, d0);
    pA0 = MFMA(kf[0], qr[0], bz); pA1 = MFMA(kf[1], qr[0], bz); pA0 = MFMA(kf[2], qr[1], pA0); pA1 = MFMA(kf[3], qr[1], pA1);
    pA0 = MFMA(kf[4], qr[2], pA0); pA1 = MFMA(kf[5], qr[2], pA1); pA0 = MFMA(kf[6], qr[3], pA0); pA1 = MFMA(kf[7], qr[3], pA1);
    if (MODE == 0) cmask(pA0, pA1, 3, qrel, hi); else wmask(pA0, pA1, (unsigned)mw, (unsigned)(mw >> 32), hi);
    { const float b0 = BT0(0), b1 = b0 + 32.f * sl2;
      const float rm = halfmax(__builtin_fmaxf(__builtin_fmaf(max16(pA0), C2, b0), __builtin_fmaf(max16(pA1), C2, b1)));
      mhat = __builtin_fmaxf(rm, -1e30f); const float nmh0 = b0 - mhat, nmh1 = b1 - mhat;
#pragma unroll
      for (int r = 0; r < 16; ++r) { pA0[r] = EX0(pA0[r]); pA1[r] = EX1(pA1[r]); } }
    WAIT_BAR(0);
    DMA_K(3, 0); DMA_V(1, SLOTB); ROT();
    _Pragma("unroll") for (int d0 = 0; d0 < 4; ++d0) kload2(kf, kp0 + sl_cur, d0);
    WAIT_BAR(3);
#define PKW(P, i) cvtpk(P[i], P[i + 1])
#define PAF(k) __builtin_bit_cast(bf16x8, pw##k)
#define VFR(i) (bf16x8){vlo[i][0], vlo[i][1], vlo[i][2], vlo[i][3], vhi[i][0], vhi[i][1], vhi[i][2], vhi[i][3]}
#define VRD2(i) do { vlo[i] = vtr(vp_ + (8192 + ((i) >> 2) * 4096 + ((i) & 3) * 1024)); vhi[i] = vtr(vp_ + (8192 + ((i) >> 2) * 4096 + ((i) & 3) * 1024 + 512)); } while (0)
#define VRD(i) do { vlo[i] = vtr(vp_ + (((i) >> 2) * 4096 + ((i) & 3) * 1024)); vhi[i] = vtr(vp_ + (((i) >> 2) * 4096 + ((i) & 3) * 1024 + 512)); } while (0)
#define KRD(G, d0) do { if (G) { kload2(kf, kp0 + sl_next, d0); SBAR(); } } while (0)
#define GAPA(MF, a0, a1, a2, a3, W0, W1, PW) do { MF; sacc += a0; sacc += a1; sacc += a2; sacc += a3; W0; W1; PIN(PW); PIN(sacc); SBAR(); } while (0)
#define GAPH0(MF, X, i) do { MF; X[i] = EX0(X[i]); X[i + 1] = EX0(X[i + 1]); PIN(X); SBAR(); } while (0)
#define GAPH1(MF, X, i) do { MF; X[i] = EX1(X[i]); X[i + 1] = EX1(X[i + 1]); PIN(X); SBAR(); } while (0)
#define GAPB0(MF, X, i) do { MF; X[i] = EX0(X[i]); X[i + 1] = EX0(X[i + 1]); X[i + 2] = EX0(X[i + 2]); X[i + 3] = EX0(X[i + 3]); PIN(X); SBAR(); } while (0)
#define GAPB1(MF, X, i) do { MF; X[i] = EX1(X[i]); X[i + 1] = EX1(X[i + 1]); X[i + 2] = EX1(X[i + 2]); X[i + 3] = EX1(X[i + 3]); PIN(X); SBAR(); } while (0)
#define STEP(C0, C1, P0, P1, t, MASK, GK, GV, GL) do { SBAR(); \
    const lds_cptr vp_ = vp0 + 2 * sl_prev; \
    if (MODE == 1) mw = *(const unsigned long long*)((const char*)maskp + (moff + 8u * (unsigned)(NT - 1 - (t)))); \
    VRD(0); SBAR(); float sacc = P0[0] + P0[1]; \
                    GAPA(C0 = MFMA(kf[0], qr[0], bz), P0[2], P0[3], P0[4], P0[5],     pw0[0] = PKW(P0, 0),  pw0[1] = PKW(P0, 2),  pw0); \
    VRD(4); SBAR(); GAPA(C1 = MFMA(kf[1], qr[0], bz), P0[6], P0[7], P0[8], P0[9],     pw0[2] = PKW(P0, 4),  pw0[3] = PKW(P0, 6),  pw0); \
    VRD(1); SBAR(); GAPA(C0 = MFMA(kf[2], qr[1], C0),    P0[10], P0[11], P0[12], P0[13], pw1[0] = PKW(P0, 8),  pw1[1] = PKW(P0, 10), pw1); \
    VRD(5); SBAR(); GAPA(C1 = MFMA(kf[3], qr[1], C1),    P0[14], P0[15], P1[0], P1[1],   pw1[2] = PKW(P0, 12), pw1[3] = PKW(P0, 14), pw1); \
    VRD(2); SBAR(); GAPA(C0 = MFMA(kf[4], qr[2], C0),    P1[2], P1[3], P1[4], P1[5],     pw2[0] = PKW(P1, 0),  pw2[1] = PKW(P1, 2),  pw2); \
    VRD(6); SBAR(); GAPA(C1 = MFMA(kf[5], qr[2], C1),    P1[6], P1[7], P1[8], P1[9],     pw2[2] = PKW(P1, 4),  pw2[3] = PKW(P1, 6),  pw2); \
    VRD(3); SBAR(); GAPA(C0 = MFMA(kf[6], qr[3], C0),    P1[10], P1[11], P1[12], P1[13], pw3[0] = PKW(P1, 8),  pw3[1] = PKW(P1, 10), pw3); \
    VRD(7); SBAR(); GAPA(C1 = MFMA(kf[7], qr[3], C1),    P1[14], P1[15], 0.f, 0.f,       pw3[2] = PKW(P1, 12), pw3[3] = PKW(P1, 14), pw3); \
    l_reg += sacc; \
    if (MODE == 1) wmask(C0, C1, (unsigned)mw, (unsigned)(mw >> 32), hi); \
    if (GK) DMA_K((t) + 3, sl_cur); if (GV) DMA_V((t) + 1, sl_next); \
    if (MODE == 0) { if (MASK) cmask(C0, C1, 3 - (t), qrel, hi); } \
    const float b0_ = BT0(t), b1_ = b0_ + 32.f * sl2; \
    { const float rma = halfmax(__builtin_fmaxf(__builtin_fmaf(max16(C0), C2, b0_), __builtin_fmaf(max16(C1), C2, b1_))); resc = false;     \
      if (__builtin_expect(__any(rma - mhat > (float)THR), 0)) { const float mn_ = __builtin_fmaxf(mhat, rma); \
          const float f = __builtin_amdgcn_exp2f(mhat - mn_); mhat = mn_; l_reg *= f; if (hi == 0) wsf[r32] = f; resc = true; } } \
    const float nmh0 = b0_ - mhat, nmh1 = b1_ - mhat; SBAR(); \
    GAPH0(o[0] = MFMA(PAF(0), VFR(0), o[0]), C0, 0);  VRD2(0); SBAR(); GAPH0(o[1] = MFMA(PAF(0), VFR(4), o[1]), C0, 2);  VRD2(4); SBAR(); \
    GAPH0(o[0] = MFMA(PAF(1), VFR(1), o[0]), C0, 4);  VRD2(1); SBAR(); GAPH0(o[1] = MFMA(PAF(1), VFR(5), o[1]), C0, 6);  VRD2(5); SBAR(); \
    GAPH0(o[0] = MFMA(PAF(2), VFR(2), o[0]), C0, 8);  VRD2(2); SBAR(); GAPH0(o[1] = MFMA(PAF(2), VFR(6), o[1]), C0, 10); VRD2(6); SBAR(); \
    GAPH0(o[0] = MFMA(PAF(3), VFR(3), o[0]), C0, 12); VRD2(3); SBAR(); GAPH0(o[1] = MFMA(PAF(3), VFR(7), o[1]), C0, 14); VRD2(7); SBAR(); \
    KRD(GL, 0); GAPH1(o[2] = MFMA(PAF(0), VFR(0), o[2]), C1, 0);  KRD(GL, 1); GAPH1(o[3] = MFMA(PAF(0), VFR(4), o[3]), C1, 2); \
    KRD(GL, 2); GAPH1(o[2] = MFMA(PAF(1), VFR(1), o[2]), C1, 4);  KRD(GL, 3); GAPH1(o[3] = MFMA(PAF(1), VFR(5), o[3]), C1, 6); \
    GAPH1(o[2] = MFMA(PAF(2), VFR(2), o[2]), C1, 8);              GAPH1(o[3] = MFMA(PAF(2), VFR(6), o[3]), C1, 10); \
    GAPH1(o[2] = MFMA(PAF(3), VFR(3), o[2]), C1, 12);             GAPH1(o[3] = MFMA(PAF(3), VFR(7), o[3]), C1, 14); \
    } while (0)
#define ENDW(tt) do { if ((tt) + 3 < NT) { WAIT_BAR(3); } else if ((tt) + 2 < NT) { WAIT_BAR(2); } else { WAIT_BAR(0); } } while (0)
    int t = 1;
    for (; t <= 3 && t + 1 < NT; t += 2) {
        STEP(pB0, pB1, pA0, pA1, t, (t <= 3), (t + 3 < NT), (t + 1 < NT), (t + 1 < NT));             ENDW(t);     RESC(); ROT();
        STEP(pA0, pA1, pB0, pB1, t + 1, (t + 1 <= 3), (t + 4 < NT), (t + 2 < NT), (t + 2 < NT));     ENDW(t + 1); RESC(); ROT();
    }
    for (; t + 5 < NT; t += 2) {
        STEP(pB0, pB1, pA0, pA1, t, false, true, true, true);     WAIT_BAR(3); RESC(); ROT();
        STEP(pA0, pA1, pB0, pB1, t + 1, false, true, true, true); WAIT_BAR(3); RESC(); ROT();
    }
    for (; t + 1 < NT; t += 2) {
        STEP(pB0, pB1, pA0, pA1, t, (t <= 3), (t + 3 < NT), (t + 1 < NT), (t + 1 < NT));             ENDW(t);     RESC(); ROT();
        STEP(pA0, pA1, pB0, pB1, t + 1, (t + 1 <= 3), (t + 4 < NT), (t + 2 < NT), (t + 2 < NT));     ENDW(t + 1); RESC(); ROT();
    }
    STEP(pB0, pB1, pA0, pA1, NT - 1, (NT - 1 <= 3), false, false, false); RESC();
    { float sacc = pB0[0] + pB0[1];
#pragma unroll
      for (int r = 2; r < 16; ++r) sacc += pB0[r];
#pragma unroll
      for (int r = 0; r < 16; ++r) sacc += pB1[r];
      l_reg += sacc;
      pw0 = (u32x4){PKW(pB0, 0), PKW(pB0, 2), PKW(pB0, 4), PKW(pB0, 6)}; pw1 = (u32x4){PKW(pB0, 8), PKW(pB0, 10), PKW(pB0, 12), PKW(pB0, 14)};
      pw2 = (u32x4){PKW(pB1, 0), PKW(pB1, 2), PKW(pB1, 4), PKW(pB1, 6)}; pw3 = (u32x4){PKW(pB1, 8), PKW(pB1, 10), PKW(pB1, 12), PKW(pB1, 14)};
      const lds_cptr vp_ = vp0 + 2 * sl_cur; _Pragma("unroll") for (int i = 0; i < 8; ++i) VRD(i);
      o[0] = MFMA(PAF(0), VFR(0), o[0]); o[1] = MFMA(PAF(0), VFR(4), o[1]); o[0] = MFMA(PAF(1), VFR(1), o[0]); o[1] = MFMA(PAF(1), VFR(5), o[1]);
      o[0] = MFMA(PAF(2), VFR(2), o[0]); o[1] = MFMA(PAF(2), VFR(6), o[1]); o[0] = MFMA(PAF(3), VFR(3), o[0]); o[1] = MFMA(PAF(3), VFR(7), o[1]);
      SBAR(); _Pragma("unroll") for (int i = 0; i < 8; ++i) VRD2(i);
      o[2] = MFMA(PAF(0), VFR(0), o[2]); o[3] = MFMA(PAF(0), VFR(4), o[3]); o[2] = MFMA(PAF(1), VFR(1), o[2]); o[3] = MFMA(PAF(1), VFR(5), o[3]);
      o[2] = MFMA(PAF(2), VFR(2), o[2]); o[3] = MFMA(PAF(2), VFR(6), o[3]); o[2] = MFMA(PAF(3), VFR(3), o[2]); o[3] = MFMA(PAF(3), VFR(7), o[3]); }
    { auto rr = __builtin_amdgcn_permlane32_swap(__float_as_uint(l_reg), __float_as_uint(l_reg), false, false); l_reg = __uint_as_float(rr[0]) + __uint_as_float(rr[1]); }
    if (hi == 0) wsf[32 + r32] = l_reg; asm volatile("s_waitcnt lgkmcnt(0)" ::: "memory");
    float rli[16];
#pragma unroll
    for (int r = 0; r < 16; ++r) rli[r] = __builtin_amdgcn_rcpf(wsf[32 + crow(r, hi)]);
    bf16_t* Ow = Oh + (size_t)(rowbase + q0 + wid * QBLK) * OP; bf16_t* stg = (bf16_t*)lds + wid * 4096;
    asm volatile("s_waitcnt lgkmcnt(0)\n\ts_barrier" ::: "memory");
#pragma unroll
    for (int r = 0; r < 16; ++r) { const int orow = crow(r, hi);
#pragma unroll
        for (int d0 = 0; d0 < 4; ++d0) stg[orow * 128 + d0 * 32 + r32] = (bf16_t)f2bf(o[d0][r] * rli[r]); }
    asm volatile("s_waitcnt lgkmcnt(0)" ::: "memory");
#pragma unroll
    for (int i = 0; i < 8; ++i) { const int row = i * 4 + (lane >> 4), ch = lane & 15; *(u32x4*)(Ow + (size_t)row * OP + ch * 8) = *(const u32x4*)(stg + row * 128 + ch * 8); }
    asm volatile("s_waitcnt lgkmcnt(0)\n\ts_barrier" ::: "memory");
#undef DMA_K
#undef DMA_V
#undef ROT
#undef EX0
#undef EX1
#undef BT0
#undef RESC
#undef PKW
#undef PAF
#undef VFR
#undef VRD
#undef VRD2
#undef GAPH0
#undef GAPH1
#undef KRD
#undef ENDW
#undef GAPA
#undef GAPB0
#undef GAPB1
#undef STEP
}
#undef SBAR
#undef PIN
#undef MFMA
#undef WAIT_BAR
#undef MX3
}

__device__ __forceinline__ void diff_attn_phase(const Frame& F, const bf16_t* H, bf16_t* OD) {
    for (int u = F.vcu; u < 512; u += F.G) {
        const int v = u & 255, i = u >> 8, bhc = v >> 3, s = v & 7;
        const int qb = (i == 0) ? 15 - s : s;
        const int b = bhc >> 3, h = (bhc >> 1) & 3, c = bhc & 1;
        const float sl2 = exp2f(-2.0f * (float)(h + 1)) * att::LOG2E;
        const int tidl = F.wave * 64 + fresh_lane();
        att::attn_unit_w(H + O_QC + h * 128 + c * 64, H + O_KC + h * 128 + c * 64, H + O_VC + h * 128, OD + h * 256 + c * 128,
                         ODD_IN, ODD_IN, ODD_IN, D_, b * S_, qb, sl2, nullptr, (char*)F.lds, tidl);
    }
}
__device__ __forceinline__ void dsa_attn_phase(const Frame& F, const bf16_t* H, const unsigned long long* MASK, bf16_t* Y) {
    for (int u = F.vcu; u < 512; u += F.G) {
        const int v = u & 255, i = u >> 8, pair = v >> 3, s = v & 7;
        const int qb = (i == 0) ? s : 15 - s;
        const int b = pair >> 3, h = pair & 7;
        const float sl2 = exp2f(-(float)(h + 1)) * att::LOG2E;
        const int tidl = F.wave * 64 + fresh_lane();
        att::attn_unit<1>(H + E_Q + h * 64, H + E_K + h * 64, H + E_V + h * 64, Y + 512 + h * 64, EVEN_PAD, EVEN_PAD, EVEN_PAD, D_, b * S_, qb, sl2,
                          MASK + ((size_t)b * S_ + qb * 256) * 64, (char*)F.lds, tidl);
    }
}
__device__ __forceinline__ void diff_combine_phase(const Frame& F, const bf16_t* OD, const float* lq1, const float* lk1, const float* lq2, const float* lk2, const float* subg, bf16_t* Y) {
    const int lane = F.lane;
    const float lam_init = 0.8f - 0.6f * expf(-0.3f);
    const float s1 = wave_sum(lq1[lane] * lk1[lane]), s2 = wave_sum(lq2[lane] * lk2[lane]);
    const float lam = expf(s1) - expf(s2) + lam_init;
    const int h = lane >> 4, e0 = (lane & 15) * 8;
    float gsc[8];
#pragma unroll
    for (int j = 0; j < 8; ++j) gsc[j] = subg[e0 + j] * (1.0f - lam_init);
    for (int tok = F.gw; tok < NTOK; tok += F.NGW) {
        const u32x4 a = *(const u32x4*)(OD + (size_t)tok * D_ + h * 256 + e0), bq = *(const u32x4*)(OD + (size_t)tok * D_ + h * 256 + 128 + e0);
        float r[8];
        r[0] = bflo(a.x) - lam * bflo(bq.x); r[1] = bfhi(a.x) - lam * bfhi(bq.x); r[2] = bflo(a.y) - lam * bflo(bq.y); r[3] = bfhi(a.y) - lam * bfhi(bq.y);
        r[4] = bflo(a.z) - lam * bflo(bq.z); r[5] = bfhi(a.z) - lam * bfhi(bq.z); r[6] = bflo(a.w) - lam * bflo(bq.w); r[7] = bfhi(a.w) - lam * bfhi(bq.w);
        float ss = 0.f;
#pragma unroll
        for (int j = 0; j < 8; ++j) ss += r[j] * r[j];
        ss += __shfl_xor(ss, 1); ss += __shfl_xor(ss, 2); ss += __shfl_xor(ss, 4); ss += __shfl_xor(ss, 8);
        const float rs = rsqrtf(ss * (1.0f / 128.0f) + RMS_EPS);
        u32x4 w; w.x = pk2(r[0] * rs * gsc[0], r[1] * rs * gsc[1]); w.y = pk2(r[2] * rs * gsc[2], r[3] * rs * gsc[3]); w.z = pk2(r[4] * rs * gsc[4], r[5] * rs * gsc[5]); w.w = pk2(r[6] * rs * gsc[6], r[7] * rs * gsc[7]);
        *(u32x4*)(Y + (size_t)tok * D_ + h * 128 + e0) = w;
    }
}


namespace dil {
typedef float f32x16 __attribute__((ext_vector_type(16)));
typedef short s16x4 __attribute__((ext_vector_type(4)));
constexpr float C2 = 0.125f * 1.4426950408889634f, LOG2E = 1.4426950408889634f;
#define DMFMA(a, b, c) __builtin_amdgcn_mfma_f32_32x32x16_bf16(a, b, c, 0, 0, 0)
template <int PH> __device__ __forceinline__ void tile_desc(int j, int& g, int& tile) {
    if (PH == 0) { g = 0; tile = 4 - j; } else { g = j < 8 ? 1 : 2; tile = j < 8 ? 7 - j : 12 - j; } }
__device__ __forceinline__ int clamp_s(int sk) { return sk < 0 ? 0 : (sk > S_ - 1 ? S_ - 1 : sk); }
template <int PH> __device__ __forceinline__ void dil_task(const Frame& F, const bf16_t* H, bf16_t* Y, float* PB, float2* PM, int b, int h, int blk, int sub) {
        constexpr int NT = PH == 0 ? 5 : 13, QS = PH == 0 ? 1 : 16;
        const int lane = fresh_lane();
        const int r32 = lane & 31, hi = lane >> 5;
        char* ldsw = (char*)F.lds + F.wave * 16384;
        const unsigned ldsv = (unsigned)(uintptr_t)ldsw;
        const att::lds_cptr vp0 = (att::lds_cptr)ldsw + 8192 + ((lane >> 4) & 1) * 32 + (lane & 3) * 8 + (4 * hi + ((lane & 15) >> 2)) * 64;
        const att::lds_cptr kp0 = (att::lds_cptr)ldsw + r32 * 128;
        const int u0 = blk * 512 + (PH == 0 ? 32 * sub : sub); const size_t rb = (size_t)b * S_;
        const float sl2 = exp2f(-(float)(h + 1)) * LOG2E;
        const bf16_t* Qp = H + (rb + u0 + QS * r32) * ODD_IN + O_QD + h * 64 + 8 * hi;
        const bf16_t* Kb = H + rb * ODD_IN + O_KD + h * 64 + ((lane & 7) ^ (lane >> 3)) * 8;
        const bf16_t* Vb = H + rb * ODD_IN + O_VD + h * 64 + (lane & 3) * 8;
        asm volatile("s_waitcnt vmcnt(0)" ::: "memory");
#define DIL_ISSUE(j_) do { int g_, tl_; tile_desc<PH>((j_), g_, tl_); const int st_ = 1 << (2 * g_), s0_ = u0 - (128 << (2 * g_)) + (st_ << 5) * tl_; \
            const unsigned kdst_ = (unsigned)__builtin_amdgcn_readfirstlane(ldsv + ((j_) & 1) * 4096), vdst_ = kdst_ + 8192u; \
            if (s0_ >= 0 && s0_ + 31 * st_ < S_) {              \
                const bf16_t* kp_ = Kb + (size_t)(s0_ + st_ * (lane >> 3)) * ODD_IN; const bf16_t* vp_ = Vb + (size_t)(s0_ + st_ * (lane >> 2)) * ODD_IN; const size_t ks_ = (size_t)(8 * st_) * ODD_IN; \
                _Pragma("unroll") for (int c = 0; c < 4; ++c) att::glds16(kp_ + c * ks_, kdst_ + c * 1024); \
                _Pragma("unroll") for (int c = 0; c < 4; ++c) att::glds16(vp_ + (c & 1) * 2 * ks_ + (c >> 1) * 32, vdst_ + c * 1024); \
            } else { \
                _Pragma("unroll") for (int c = 0; c < 4; ++c) { const int sk = clamp_s(s0_ + st_ * (8 * c + (lane >> 3))); att::glds16(Kb + (size_t)sk * ODD_IN, kdst_ + c * 1024); } \
                _Pragma("unroll") for (int c = 0; c < 4; ++c) { const int sk = clamp_s(s0_ + st_ * (16 * (c & 1) + (lane >> 2))); att::glds16(Vb + (size_t)sk * ODD_IN + (c >> 1) * 32, vdst_ + c * 1024); } } } while (0)
        DIL_ISSUE(0);
        bf16x8 qr[4];
#pragma unroll
        for (int d0 = 0; d0 < 4; ++d0) qr[d0] = *(const bf16x8*)(Qp + 16 * d0);
        float mhat = -1e30f, l_reg = 0.f; f32x16 o[2]; o[0] = f32x16{}; o[1] = f32x16{};
        if (PH == 1) {
            const float2 ml = PM[sub + 16 * r32]; mhat = ml.x; l_reg = hi ? 0.f : ml.y;
            const float* PBp = PB + (size_t)sub * 64 + r32;
#pragma unroll
            for (int r = 0; r < 16; ++r) { const int row = att::crow(r, hi); o[0][r] = PBp[(size_t)(16 * row) * 64]; o[1][r] = PBp[(size_t)(16 * row) * 64 + 32]; }
        }
        asm volatile("" : "+v"(o[0]), "+v"(o[1]), "+v"(mhat), "+v"(l_reg), "+v"(qr[0]), "+v"(qr[1]), "+v"(qr[2]), "+v"(qr[3]));
        int gprev = -1; f32x16 bz = f32x16{};
#pragma unroll 1
        for (int j = 0; j < NT; ++j) {
            int g, tile; tile_desc<PH>(j, g, tile);
            const int ST = 1 << (2 * g), W = 128 << (2 * g);
            if (g != gprev) { gprev = g;
#pragma unroll
                for (int r = 0; r < 16; ++r) bz[r] = sl2 * (float)(ST * ((r & 3) + 8 * (r >> 2) + 4 * hi)) * (1.0f / C2); }
            const int s0t = u0 - W + ST * 32 * tile;
            if (j + 1 < NT) { DIL_ISSUE(j + 1); asm volatile("s_waitcnt vmcnt(8)" ::: "memory"); } else asm volatile("s_waitcnt vmcnt(0)" ::: "memory");
            bf16x8 kf[4];
            { const att::lds_cptr kpj = kp0 + (j & 1) * 4096;
#pragma unroll
              for (int d0 = 0; d0 < 4; ++d0) kf[d0] = *(const __attribute__((address_space(3))) bf16x8*)(kpj + (((2 * d0 + hi) ^ (r32 & 7)) * 16)); }
            f32x16 C0 = DMFMA(kf[0], qr[0], bz);
            C0 = DMFMA(kf[1], qr[1], C0); C0 = DMFMA(kf[2], qr[2], C0); C0 = DMFMA(kf[3], qr[3], C0);
            __builtin_amdgcn_sched_barrier(0);
            const int dq = QS * r32 + W - ST * 32 * tile - ST * 4 * hi;
            int kmin = 0; if (s0t < 0) kmin = (-s0t + ST - 1) >> (2 * g);
            const int km0 = kmin - 4 * hi;
            unsigned vmask;
            { const int hx = dq >> (2 * g); int lx = (dq - W + ST - 1) >> (2 * g); lx = lx > km0 ? lx : km0; lx = lx > 0 ? lx : 0;
              const unsigned up = hx >= 31 ? 0xFFFFFFFFu : ((2u << (hx & 31)) - 1u), dn = lx > 31 ? 0xFFFFFFFFu : ((1u << (lx & 31)) - 1u);
              vmask = (hx < 0 || lx > hx) ? 0u : (up & ~dn); }
#pragma unroll
            for (int r = 0; r < 16; ++r) { const int cr = (r & 3) + 8 * (r >> 2); const unsigned t_ = (unsigned)((int)(vmask << (31 - cr)) >> 31);
                C0[r] = __uint_as_float((__float_as_uint(C0[r]) & t_) | (0xff800000u & ~t_)); }
            const float nb0 = -sl2 * (float)(QS * r32 + W - ST * 32 * tile);
            const float rma = att::halfmax(__builtin_fmaf(att::max16(C0), C2, nb0));
            if (__any(rma - mhat > 6.0f)) {
                const float mn_ = __builtin_fmaxf(mhat, rma); const float f = __builtin_amdgcn_exp2f(mhat - mn_); mhat = mn_; l_reg *= f;
#pragma unroll
                for (int r = 0; r < 16; ++r) {
                    const float f0 = __builtin_bit_cast(float, __builtin_amdgcn_readlane(__builtin_bit_cast(int, f), (r & 3) + 8 * (r >> 2)));
                    const float f1 = __builtin_bit_cast(float, __builtin_amdgcn_readlane(__builtin_bit_cast(int, f), (r & 3) + 8 * (r >> 2) + 4));
                    const float fr = hi ? f1 : f0; o[0][r] *= fr; o[1][r] *= fr; }
            }
            const float nmh0 = nb0 - mhat;
            float sacc = 0.f;
#pragma unroll
            for (int r = 0; r < 16; ++r) { C0[r] = __builtin_amdgcn_exp2f(__builtin_fmaf(C0[r], C2, nmh0)); sacc += C0[r]; }
            l_reg += sacc;
            u32x4 pw0, pw1;
            pw0 = (u32x4){att::cvtpk(C0[0], C0[1]), att::cvtpk(C0[2], C0[3]), att::cvtpk(C0[4], C0[5]), att::cvtpk(C0[6], C0[7])};
            pw1 = (u32x4){att::cvtpk(C0[8], C0[9]), att::cvtpk(C0[10], C0[11]), att::cvtpk(C0[12], C0[13]), att::cvtpk(C0[14], C0[15])};
            asm volatile("s_nop 1" : "+v"(pw0), "+v"(pw1));
            {
                const att::lds_cptr vpj = vp0 + (j & 1) * 4096;
                s16x4 vlo[4], vhi[4];
#define DVFR(i) (bf16x8){vlo[i][0], vlo[i][1], vlo[i][2], vlo[i][3], vhi[i][0], vhi[i][1], vhi[i][2], vhi[i][3]}
#pragma unroll
                for (int i = 0; i < 4; ++i) { vlo[i] = att::vtr(vpj + ((i >> 1) * 2048 + (i & 1) * 1024)); vhi[i] = att::vtr(vpj + ((i >> 1) * 2048 + (i & 1) * 1024 + 512)); }
                o[0] = DMFMA(__builtin_bit_cast(bf16x8, pw0), DVFR(0), o[0]); o[1] = DMFMA(__builtin_bit_cast(bf16x8, pw0), DVFR(2), o[1]);
                o[0] = DMFMA(__builtin_bit_cast(bf16x8, pw1), DVFR(1), o[0]); o[1] = DMFMA(__builtin_bit_cast(bf16x8, pw1), DVFR(3), o[1]);
                __builtin_amdgcn_sched_barrier(0);
#undef DVFR
            }
            asm volatile("s_waitcnt lgkmcnt(0)" ::: "memory");
        }
#undef DIL_ISSUE
        { auto rr = __builtin_amdgcn_permlane32_swap(__float_as_uint(l_reg), __float_as_uint(l_reg), false, false); l_reg = __uint_as_float(rr[0]) + __uint_as_float(rr[1]); }
        const int lane3 = fresh_lane();
        const int hi3 = lane3 >> 5;
        if (PH == 0) {
            float* PBp = PB + (size_t)(32 * sub) * 64 + (lane3 & 31);
#pragma unroll
            for (int r = 0; r < 16; ++r) { const int row = att::crow(r, hi3); PBp[row * 64] = o[0][r]; PBp[row * 64 + 32] = o[1][r]; }
            if (hi3 == 0) PM[32 * sub + lane3] = make_float2(mhat, l_reg);
        } else {
            const float rl = __builtin_amdgcn_rcpf(l_reg);
            bf16_t* Yp = Y + (rb + u0) * D_ + 512 + h * 64 + (lane3 & 31);
#pragma unroll
            for (int r = 0; r < 16; ++r) { const int row = att::crow(r, hi3); const float rli = __shfl(rl, row);
                Yp[(size_t)(16 * row) * D_] = (bf16_t)f2bf(o[0][r] * rli); Yp[(size_t)(16 * row) * D_ + 32] = (bf16_t)f2bf(o[1][r] * rli); }
        }
}
__device__ __forceinline__ void dil_phase(const Frame& F, const bf16_t* H, bf16_t* Y, float* PBALL) {
    for (int unit = F.vcu; unit < 256; unit += F.G) {
        const int h = unit & 7, blk = (unit >> 3) & 7, b = unit >> 6;
        float* PB = PBALL + (size_t)unit * (512 * 64 + 1024); float2* PM = (float2*)(PB + 512 * 64);
        dil_task<0>(F, H, Y, PB, PM, b, h, blk, F.wave); dil_task<0>(F, H, Y, PB, PM, b, h, blk, F.wave + 8);
        __syncthreads();
        dil_task<1>(F, H, Y, PB, PM, b, h, blk, F.wave); dil_task<1>(F, H, Y, PB, PM, b, h, blk, F.wave + 8);
        __syncthreads();
    }
}
#undef DMFMA
}

template <bool XBF>
__device__ __forceinline__ void ln_router_phase(const Frame& F, const void* xin_, const bf16_t* Mb, const float* g, const float* bta, const float* rw, const float* rb,
                                                bf16_t* X1B, int* bcnt, const bool dry = false) {
    typedef float f32x16 __attribute__((ext_vector_type(16)));
    LAS int* lcnt = (LAS int*)(F.lds + ROUTE_OFF);
    LAS int* recs = (LAS int*)(F.lds + ROUTE_OFF + 256);
    if (F.tid < NE) lcnt[F.tid] = 0;
    LAS float* yl = (LAS float*)F.lds;
    LAS float* pl = (LAS float*)F.lds;
    const int lane = F.lane;
    f32x4 gv[4], bv[4];
#pragma unroll
    for (int j = 0; j < 4; ++j) { gv[j] = *((const f32x4*)g + lane + 64 * j); bv[j] = *((const f32x4*)bta + lane + 64 * j); }
    float bw[64];
    { const float* bptr = rw + (size_t)(F.wave * 128 + (lane >> 5) * 64) * NE + (lane & 31);
#pragma unroll
      for (int ii = 0; ii < 64; ++ii) bw[ii] = bptr[ii * NE]; }
    f32x4 xv[4][4]; u32x2 mv[4][4];
#define LNR_LOAD_ROWS(t_) do { _Pragma("unroll") for (int q = 0; q < 4; ++q) { const int row = F.gw + F.NGW * (4 * (t_) + q); const u32x2* mr = (const u32x2*)(Mb + (size_t)row * D_) + lane; \
        _Pragma("unroll") for (int j = 0; j < 4; ++j) { \
            if (XBF) { const u32x2 xw = ((const u32x2*)((const bf16_t*)xin_ + (size_t)row * D_) + lane)[64 * j]; xv[q][j] = (f32x4){bflo(xw.x), bfhi(xw.x), bflo(xw.y), bfhi(xw.y)}; } \
            else xv[q][j] = ((const f32x4*)((const float*)xin_ + (size_t)row * D_) + lane)[64 * j]; \
            mv[q][j] = mr[64 * j]; } } } while (0)
    LNR_LOAD_ROWS(0);
    const float rbv = lane < NE ? rb[lane] : 0.f;
#pragma unroll
    for (int t = 0; t < 2; ++t) {
#pragma unroll
        for (int q = 0; q < 4; ++q) {
            const int row = F.gw + F.NGW * (4 * t + q), i = F.wave + 8 * q;
            f32x4 v[4]; float s = 0.f;
#pragma unroll
            for (int j = 0; j < 4; ++j) { const f32x4 x = xv[q][j]; const u32x2 mw = mv[q][j];
                v[j][0] = ALPHA * x[0] + bflo(mw.x); v[j][1] = ALPHA * x[1] + bfhi(mw.x); v[j][2] = ALPHA * x[2] + bflo(mw.y); v[j][3] = ALPHA * x[3] + bfhi(mw.y);
                s += (v[j][0] + v[j][1]) + (v[j][2] + v[j][3]); }
            const float mean = wave_sum_u(s) * (1.0f / D_); float qq = 0.f;
#pragma unroll
            for (int j = 0; j < 4; ++j) { v[j] = v[j] - mean; qq += (v[j][0] * v[j][0] + v[j][1] * v[j][1]) + (v[j][2] * v[j][2] + v[j][3] * v[j][3]); }
            const float rstd = rsqrtf(wave_sum_u(qq) * (1.0f / D_) + LN_EPS);
            u32x2* x1b = (u32x2*)(X1B + (size_t)row * D_) + lane;
#pragma unroll
            for (int j = 0; j < 4; ++j) { v[j] = v[j] * rstd * gv[j] + bv[j]; u32x2 w; w.x = pk2(v[j][0], v[j][1]); w.y = pk2(v[j][2], v[j][3]); x1b[64 * j] = w;
                *(LAS f32x4*)(yl + i * 1024 + 4 * ((lane + 64 * j) ^ (i & 15))) = v[j]; }
        }
        __syncthreads();
        {
            const int r = lane & 31, kh = lane >> 5, cb = F.wave * 32 + kh * 16;
            float v[64];
#pragma unroll
            for (int m = 0; m < 16; ++m) { const f32x4 y4 = *(const LAS f32x4*)(yl + r * 1024 + 4 * ((cb + m) ^ (r & 15))); v[4 * m] = y4[0]; v[4 * m + 1] = y4[1]; v[4 * m + 2] = y4[2]; v[4 * m + 3] = y4[3]; }
            f32x16 acc = {0.f, 0.f, 0.f, 0.f, 0.f, 0.f, 0.f, 0.f, 0.f, 0.f, 0.f, 0.f, 0.f, 0.f, 0.f, 0.f};
#pragma unroll
            for (int ii = 0; ii < 64; ++ii) acc = __builtin_amdgcn_mfma_f32_32x32x2f32(v[ii], bw[ii], acc, 0, 0, 0);
            __syncthreads();
#pragma unroll
            for (int rr = 0; rr < 16; ++rr) pl[(F.wave * 32 + (rr & 3) + 8 * (rr >> 2) + 4 * kh) * 32 + r] = acc[rr];
        }
        __syncthreads();
        if (t == 0) LNR_LOAD_ROWS(1);
        for (int q = 0; q < 4; ++q) {
            const int it_ = 4 * t + q, i = F.wave + 8 * q;
            float logit = -INFINITY;
            if (lane < NE) { const LAS float* pp = pl + i * 32 + lane;
                logit = (((pp[0] + pp[1024]) + (pp[2048] + pp[3072])) + ((pp[4096] + pp[5120]) + (pp[6144] + pp[7168]))) + rbv; }
            float tv[TOPK]; int ti[TOPK];
#pragma unroll
            for (int k = 0; k < TOPK; ++k) {
                const float mx = wave_max_u(logit);
                const int bi = (int)__builtin_ctzll(__ballot(logit == mx));
                tv[k] = mx; ti[k] = bi; if (lane == bi) logit = -INFINITY;
            }
            float ex[TOPK], den = 0.f;
#pragma unroll
            for (int k = 0; k < TOPK; ++k) { ex[k] = __expf(tv[k] - tv[0]); den += ex[k]; }
            if (lane < TOPK) {
                int e = ti[0]; float gt = ex[0];
#pragma unroll
                for (int k = 1; k < TOPK; ++k) if (lane == k) { e = ti[k]; gt = ex[k]; }
                const int lr = __hip_atomic_fetch_add((LAS int*)&lcnt[e], 1, __ATOMIC_RELAXED, __HIP_MEMORY_SCOPE_WORKGROUP);
                LAS int* rc = recs + ((F.wave * 8 + it_) * 4 + lane) * 3; rc[0] = e; rc[1] = lr; rc[2] = (int)__float_as_uint(gt / den);
            }
        }
        __syncthreads();
    }
#undef LNR_LOAD_ROWS
    __syncthreads();
    if (F.tid < NE && !dry) bcnt[F.vcu * NE + F.tid] = lcnt[F.tid];
}

__device__ __forceinline__ int route_fill(const Frame& F, const int* bcnt, int* tk_e, int* tk_rank, float* tk_gate, int* slot_tok) {
    LAS int* tile_e = (LAS int*)(F.lds + TILE_E_OFF); LAS int* tile_f = (LAS int*)(F.lds + TILE_F_OFF); LAS int* ebase = (LAS int*)(F.lds + EBASE_OFF); LAS int* ecnt = (LAS int*)(F.lds + ECNT_OFF);
    LAS int* lbase = (LAS int*)(F.lds + ROUTE_OFF); const LAS int* recs = (const LAS int*)(F.lds + ROUTE_OFF + 256); LAS int* part = (LAS int*)(F.lds + ROUTE_OFF + 3328);
    { const int e = F.tid & 31, p = F.tid >> 5; int sa = 0, sb = 0;
      for (int v = p * 16; v < p * 16 + 16; ++v) if (v < F.G) { const int c = bcnt[v * NE + e]; sa += c; sb += (v < F.vcu) ? c : 0; }
      part[(p * 32 + e) * 2] = sa; part[(p * 32 + e) * 2 + 1] = sb; }
    __syncthreads();
    if (F.tid < NE) { int sa = 0, sb = 0; for (int p = 0; p < 16; ++p) { sa += part[(p * 32 + F.tid) * 2]; sb += part[(p * 32 + F.tid) * 2 + 1]; } ecnt[F.tid] = sa; lbase[F.tid] = sb; }
    __syncthreads();
    if (F.tid == 0) { int run = 0; for (int e = 0; e < NE; ++e) { ebase[e] = run; run += (ecnt[e] + 255) / 256; } ebase[NE] = run; }
    { int it2 = 0; const int lane = F.lane;
      for (int row = F.gw; row < NTOK; row += F.NGW, ++it2) if (lane < TOPK) {
          const LAS int* rc = recs + ((F.wave * 8 + it2) * 4 + lane) * 3; const int e = rc[0], rank = lbase[e] + rc[1];
          tk_e[row * TOPK + lane] = e; tk_rank[row * TOPK + lane] = rank; tk_gate[row * TOPK + lane] = __uint_as_float((unsigned)rc[2]);
          slot_tok[e * NTOK + rank] = row; } }
    __syncthreads();
    const int ntile = ebase[NE];
    for (int tl = F.tid; tl < ntile; tl += NTHR) { int e = 0; while (e + 1 < NE && ebase[e + 1] <= tl) ++e; tile_e[tl] = e; tile_f[tl] = tl - ebase[e]; }
    __syncthreads();
    return ntile;
}

__device__ __forceinline__ void combine_ln_phase(const Frame& F, const bf16_t* X1B, const bf16_t* YA, const int* tk_e, const int* tk_rank, const float* tk_gate,
                                                 const float* g, const float* bta, float* out, bf16_t* XB) {
    const LAS int* ebase = (const LAS int*)(F.lds + EBASE_OFF);
    const int lane = F.lane;
    f32x4 gv[4], bv[4];
#pragma unroll
    for (int j = 0; j < 4; ++j) { gv[j] = *((const f32x4*)g + lane + 64 * j); bv[j] = *((const f32x4*)bta + lane + 64 * j); }
    for (int row0 = F.gw; row0 < NTOK; row0 += 2 * F.NGW) {
        int rows[2]; rows[0] = row0; rows[1] = row0 + F.NGW < NTOK ? row0 + F.NGW : row0;
        const u32x2* yr[2][TOPK]; float gt[2][TOPK];
#pragma unroll
        for (int r = 0; r < 2; ++r)
#pragma unroll
            for (int k = 0; k < TOPK; ++k) { const int e = tk_e[rows[r] * TOPK + k], rk = tk_rank[rows[r] * TOPK + k]; gt[r][k] = tk_gate[rows[r] * TOPK + k];
                yr[r][k] = (const u32x2*)(YA + ((size_t)ebase[e] * 256 + rk) * D_) + lane; }
        u32x2 xw[2][4], yw[2][TOPK][4];
#pragma unroll
        for (int r = 0; r < 2; ++r) { const u32x2* xr = (const u32x2*)(X1B + (size_t)rows[r] * D_) + lane;
#pragma unroll
            for (int j = 0; j < 4; ++j) { xw[r][j] = xr[64 * j];
#pragma unroll
                for (int k = 0; k < TOPK; ++k) yw[r][k][j] = yr[r][k][64 * j]; } }
#pragma unroll
        for (int r = 0; r < 2; ++r) {
            if (r == 1 && rows[1] == rows[0]) break;
            const int row = rows[r];
            f32x4 v[4]; float s = 0.f;
#pragma unroll
            for (int j = 0; j < 4; ++j) { const f32x4 x = {bflo(xw[r][j].x), bfhi(xw[r][j].x), bflo(xw[r][j].y), bfhi(xw[r][j].y)}; f32x4 f = {0.f, 0.f, 0.f, 0.f};
#pragma unroll
                for (int k = 0; k < TOPK; ++k) { const u32x2 w = yw[r][k][j]; f[0] += gt[r][k] * bflo(w.x); f[1] += gt[r][k] * bfhi(w.x); f[2] += gt[r][k] * bflo(w.y); f[3] += gt[r][k] * bfhi(w.y); }
                v[j] = ALPHA * x + f; s += (v[j][0] + v[j][1]) + (v[j][2] + v[j][3]); }
            const float mean = wave_sum_u(s) * (1.0f / D_); float q = 0.f;
#pragma unroll
            for (int j = 0; j < 4; ++j) { v[j] = v[j] - mean; q += (v[j][0] * v[j][0] + v[j][1] * v[j][1]) + (v[j][2] * v[j][2] + v[j][3] * v[j][3]); }
            const float rstd = rsqrtf(wave_sum_u(q) * (1.0f / D_) + LN_EPS);
#pragma unroll
            for (int j = 0; j < 4; ++j) v[j] = v[j] * rstd * gv[j] + bv[j];
            if (out) { f32x4* orow = (f32x4*)(out + (size_t)row * D_) + lane;
#pragma unroll
                for (int j = 0; j < 4; ++j) orow[64 * j] = v[j]; }
            if (XB) { u32x2* xb = (u32x2*)(XB + (size_t)row * D_) + lane;
#pragma unroll
                for (int j = 0; j < 4; ++j) { u32x2 w; w.x = pk2(v[j][0], v[j][1]); w.y = pk2(v[j][2], v[j][3]); xb[64 * j] = w; } }
        }
    }
}

constexpr int PTAB_OFF = CTL_OFF + 4096;
__device__ __forceinline__ const float* ptab_ld(LAS unsigned char* lds, int i) {
    const LAS unsigned* p = (const LAS unsigned*)(lds + PTAB_OFF) + 2 * i;
    const unsigned lo = __builtin_amdgcn_readfirstlane(p[0]), hi = __builtin_amdgcn_readfirstlane(p[1]);
    return (const float*)(((unsigned long long)hi << 32) | lo);
}
#define INP(i) ptab_ld(F.lds, (i))
#define OUTP() ((float*)ptab_ld(F.lds, 31))
#define WSP() ((unsigned char*)ptab_ld(F.lds, 32))
#define LAUNDER_S(x) do { int _v = (x); asm volatile("" : "+v"(_v)); (x) = __builtin_amdgcn_readfirstlane(_v); } while (0)
#define PHASE_BEGIN() do { LAUNDER_S(F.G); LAUNDER_S(F.vcu); LAUNDER_S(F.gw); LAUNDER_S(F.NGW); LAUNDER_S(F.wave); LAUNDER_S(F.bx); \
        { int _o = -1; asm volatile("" : "+v"(_o)); const unsigned _m = (unsigned)__builtin_amdgcn_readfirstlane(_o); F.lane = (int)__builtin_amdgcn_mbcnt_hi(_m, __builtin_amdgcn_mbcnt_lo(_m, 0u)); F.tid = F.wave * 64 + F.lane; } \
        { unsigned _l = (unsigned)(uintptr_t)F.lds; asm volatile("" : "+v"(_l)); F.lds = (LAS unsigned char*)(uintptr_t)(unsigned)__builtin_amdgcn_readfirstlane((int)_l); } } while (0)
#define GRID_BAR() xcd_barrier(bar, F.wave == 0 && fresh_lane() == 0)
#define TILE_E ((const LAS int*)(F.lds + TILE_E_OFF))
#define TILE_F ((const LAS int*)(F.lds + TILE_F_OFF))
#define ECNT ((const LAS int*)(F.lds + ECNT_OFF))
template <int layer>
__device__ __forceinline__ void run_layer(Frame& F, const XcdBarrier& bar) {
        const int lb = layer == 0 ? 0 : 17;
        const int NP = layer == 0 ? EVEN_PAD : ODD_IN;
        constexpr size_t WOFF = layer == 0 ? 0 : WS_W1OFF;
        constexpr int TAIL_BATCHES = 3;
        PHASE_BEGIN();
        { unsigned char* ws = WSP(); pg8::DenseSched S; S.init(ws + WS_XB, ws + WOFF + WS_WIN, NTOK, NP, D_, F.G, F.bx); pg8::EpiBf16 E{(bf16_t*)(ws + WS_H), NP};
          pg8::gemm_phase<pg8::EpiBf16, pg8::DenseSched, false>(F.lds, D_, S, E, F.tid); }
        if (layer == 0) { const int nu_ = (NTOK / 256) * (NP / 256), my_ = (nu_ - F.bx + F.G - 1) / F.G, mx_ = (nu_ + F.G - 1) / F.G;
          if (my_ < mx_) { ConvJob J{INP(14), ODD_IN, ODD_IN, INP(20), INP(25), INP(27), WS_W1OFF}; convert_queue(F, J, (int*)(WSP() + WS_CTL) + CW_CONV, (mx_ - my_) * TAIL_BATCHES); } }
        GRID_BAR();
        PHASE_BEGIN();
        { unsigned char* ws = WSP();
          if (layer == 0) { conv_phase(F, (const bf16_t*)(ws + WS_H), INP(2), (bf16_t*)(ws + WS_Y));
                            { ConvJob J0{INP(1), EVEN_IN, EVEN_PAD, INP(3), INP(8), INP(10), 0};
                              dsa_select_phase(F, (const bf16_t*)(ws + WS_H), (unsigned long long*)(ws + WS_X1), J0, (int*)(ws + WS_CTL) + CW_CONV + 64, 16 * (EVEN_PAD / 64) + 256); } }
          else { diff_attn_phase(F, (const bf16_t*)(ws + WS_H), (bf16_t*)(ws + WS_MB));
                 dil::dil_phase(F, (const bf16_t*)(ws + WS_H), (bf16_t*)(ws + WS_Y), (float*)(ws + WS_YA)); } }
        GRID_BAR();
        if (layer == 0) { PHASE_BEGIN(); unsigned char* ws = WSP();
          dsa_attn_phase(F, (const bf16_t*)(ws + WS_H), (const unsigned long long*)(ws + WS_X1), (bf16_t*)(ws + WS_Y));
          GRID_BAR(); }
        if (layer == 1) { PHASE_BEGIN(); unsigned char* ws = WSP();
          diff_combine_phase(F, (const bf16_t*)(ws + WS_MB), INP(15), INP(16), INP(17), INP(18), INP(19), (bf16_t*)(ws + WS_Y));
          GRID_BAR(); }
        PHASE_BEGIN();
        { unsigned char* ws = WSP(); pg8::DenseSched S; S.init(ws + WS_Y, ws + WOFF + WS_WOUT, NTOK, D_, D_, F.G, F.bx); pg8::EpiBf16 E{(bf16_t*)(ws + WS_MB), D_};
          pg8::gemm_phase<pg8::EpiBf16, pg8::DenseSched, false>(F.lds, D_, S, E, F.tid); }
        GRID_BAR();
        PHASE_BEGIN();
        { unsigned char* ws = WSP();
          ln_router_phase<layer == 1>(F, layer == 0 ? (const void*)INP(0) : (const void*)(ws + WS_XB), (const bf16_t*)(ws + WS_MB), INP(4 + lb), INP(5 + lb), INP(6 + lb), INP(7 + lb),
                          (bf16_t*)(ws + WS_X1B), (int*)(ws + WS_CTL) + CW_BCNT); }
        GRID_BAR();
        PHASE_BEGIN();
        int ntile;
        { unsigned char* ws = WSP();
          ntile = route_fill(F, (const int*)(ws + WS_CTL) + CW_BCNT, (int*)(ws + WS_TKE), (int*)(ws + WS_TKR), (float*)(ws + WS_TKG), (int*)(ws + WS_SLOT)); }
        if (layer == 0) { ConvJob J0{INP(1), EVEN_IN, EVEN_PAD, INP(3), INP(8), INP(10), 0};
          convert_queue(F, J0, (int*)(WSP() + WS_CTL) + CW_CONV + 64, 1 << 30, 1, 16 * (EVEN_PAD / 64) + 256); }
        GRID_BAR();
        PHASE_BEGIN();
        { unsigned char* ws = WSP(); pg8::MoeSched S; S.A = (const char*)(ws + WS_X1B); S.Bt = (const char*)(ws + WOFF + WS_WGU); S.slot_tok = (const int*)(ws + WS_SLOT); S.tile_e = TILE_E; S.tile_f = TILE_F; S.ecnt = ECNT;
          S.NPN = 8; S.n_units = ntile * 8; S.G = F.G; S.c = F.bx; S.bexp = (size_t)2 * DFF * D_ * 2; S.gather = true;
          pg8::EpiAct E{(bf16_t*)(ws + WS_ACT), INP(9 + lb), TILE_E};
          pg8::gemm_phase<pg8::EpiAct, pg8::MoeSched, true>(F.lds, D_, S, E, F.tid); }
        if (layer == 0) { pg8::MoeSched S_; S_.NPN = 8; S_.n_units = ntile * 8; S_.G = F.G; S_.c = F.bx; const int nu_ = ntile * 8, my_ = S_.my_units(), mx_ = (nu_ + F.G - 1) / F.G;
          if (my_ < mx_) { ConvJob J{INP(14), ODD_IN, ODD_IN, INP(20), INP(25), INP(27), WS_W1OFF}; convert_queue(F, J, (int*)(WSP() + WS_CTL) + CW_CONV, (mx_ - my_) * TAIL_BATCHES); } }
        GRID_BAR();
        PHASE_BEGIN();
        { unsigned char* ws = WSP(); pg8::MoeSched S; S.A = (const char*)(ws + WS_ACT); S.Bt = (const char*)(ws + WOFF + WS_WDN); S.slot_tok = (const int*)(ws + WS_SLOT); S.tile_e = TILE_E; S.tile_f = TILE_F; S.ecnt = ECNT;
          S.NPN = 4; S.n_units = ntile * 4; S.G = F.G; S.c = F.bx; S.bexp = (size_t)D_ * DFF * 2; S.gather = false;
          pg8::EpiBias E{(bf16_t*)(ws + WS_YA), INP(11 + lb), TILE_E};
          pg8::gemm_phase<pg8::EpiBias, pg8::MoeSched, false>(F.lds, DFF, S, E, F.tid); }
        if (layer == 0) { pg8::MoeSched S_; S_.NPN = 4; S_.n_units = ntile * 4; S_.G = F.G; S_.c = F.bx; const int nu_ = ntile * 4, my_ = S_.my_units(), mx_ = (nu_ + F.G - 1) / F.G;
          if (my_ < mx_) { ConvJob J{INP(14), ODD_IN, ODD_IN, INP(20), INP(25), INP(27), WS_W1OFF}; convert_queue(F, J, (int*)(WSP() + WS_CTL) + CW_CONV, (mx_ - my_) * TAIL_BATCHES); } }
        GRID_BAR();
        PHASE_BEGIN();
        { unsigned char* ws = WSP();
          combine_ln_phase(F, (const bf16_t*)(ws + WS_X1B), (const bf16_t*)(ws + WS_YA), (const int*)(ws + WS_TKE), (const int*)(ws + WS_TKR), (const float*)(ws + WS_TKG),
                           INP(12 + lb), INP(13 + lb), layer == 0 ? (float*)nullptr : OUTP(), layer == 0 ? (bf16_t*)(ws + WS_XB) : nullptr); }
        if (layer == 0) {
            __syncthreads();
            PHASE_BEGIN();
            { ConvJob J{INP(14), ODD_IN, ODD_IN, INP(20), INP(25), INP(27), WS_W1OFF}; convert_queue(F, J, (int*)(WSP() + WS_CTL) + CW_CONV, 1 << 30, 1); }
            GRID_BAR();
        }
}

__global__ void __launch_bounds__(NTHR, 2) mega_fwd(Args args) {
    extern __shared__ __attribute__((aligned(16))) unsigned char lds_raw[];
    Frame F;
    F.lds = (LAS unsigned char*)lds_raw;
    F.tid = threadIdx.x; F.lane = F.tid & 63; F.wave = __builtin_amdgcn_readfirstlane(F.tid >> 6);
    F.G = gridDim.x; F.bx = blockIdx.x; { const int bx = blockIdx.x; F.vcu = (F.G % 8 == 0) ? (bx % 8) * (F.G / 8) + bx / 8 : bx; }
    F.gw = F.vcu * NWAVES + F.wave; F.NGW = F.G * NWAVES;
    for (int u = F.tid; u < (LDS_BYTES - CTL_OFF) / 4; u += NTHR) ((LAS unsigned*)(F.lds + CTL_OFF))[u] = 0u;
    __syncthreads();
    if (F.tid == 0) {
        LAS unsigned long long* pt = (LAS unsigned long long*)(F.lds + PTAB_OFF);
#pragma unroll
        for (int i = 0; i < 31; ++i) pt[i] = (unsigned long long)args.in[i];
        pt[31] = (unsigned long long)args.out; pt[32] = (unsigned long long)args.ws;
    }
    __syncthreads();
    F.ws = WSP();
    XcdBarrier bar = xcd_barrier_post((unsigned*)(WSP() + WS_CTL) + CW_BAR, (volatile LAS unsigned*)(F.lds + MISC_OFF) + 8);

    { ConvJob J{INP(1), EVEN_IN, EVEN_PAD, INP(3), INP(8), INP(10), 0}; convert_weights(F, J, 16 * (EVEN_PAD / 64) + 256); }
    convert_x(F, INP(0), (bf16_t*)(WSP() + WS_XB));
    if (gridDim.x == 0x7fffffffu) cg::this_grid().sync();
    GRID_BAR();

    run_layer<0>(F, bar);
    run_layer<1>(F, bar);
}

extern "C" void kernel_launch(void* const* d_in, const int* in_sizes, int n_in, void* d_out, int out_size, void* d_ws, size_t ws_size, hipStream_t stream) {
    (void)in_sizes; (void)out_size;
    static int grid = 0;
    if (grid == 0) {
        if (n_in != 31 || ws_size < WS_END) { fprintf(stderr, "kernel_launch: unexpected n_in %d or ws_size %zu\n", n_in, ws_size); grid = -1; return; }
        int dev = 0, cus = 0, per_cu = 0;
        if (hipGetDevice(&dev) != hipSuccess || hipDeviceGetAttribute(&cus, hipDeviceAttributeMultiprocessorCount, dev) != hipSuccess) { grid = -1; return; }
        if (hipFuncSetAttribute((const void*)mega_fwd, hipFuncAttributeMaxDynamicSharedMemorySize, LDS_BYTES) != hipSuccess) { fprintf(stderr, "kernel_launch: hipFuncSetAttribute failed\n"); grid = -1; return; }
        if (hipOccupancyMaxActiveBlocksPerMultiprocessor(&per_cu, (const void*)mega_fwd, NTHR, LDS_BYTES) != hipSuccess || per_cu < 1) { fprintf(stderr, "kernel_launch: occupancy query says %d\n", per_cu); per_cu = 1; }
        (void)hipGetLastError();
        grid = cus;
    }
    if (grid < 0) return;
    if (hipMemsetAsync((char*)d_ws + WS_CTL, 0, CTL_ZERO_BYTES, stream) != hipSuccess) return;
    Args a{};
    for (int i = 0; i < 31; ++i) a.in[i] = (const float*)d_in[i];
    a.out = (float*)d_out; a.ws = (unsigned char*)d_ws;
    void* kargs[] = {&a};
    hipError_t e = hipLaunchCooperativeKernel((const void*)mega_fwd, dim3(grid), dim3(NTHR), kargs, LDS_BYTES, stream);
    if (e != hipSuccess) fprintf(stderr, "kernel_launch: cooperative launch failed: %s (grid %d)\n", hipGetErrorString(e), grid);
}
```
